# Optimizing an MI355X kernel written in HIP

```python
import jax, jax.numpy as jnp
from jax import lax
import numpy as np

D_MODEL = 1024
BATCH = 4
SEQ = 8192
DEPTH = 1
DEC_BATCH = 32
DEC_SEQ = 32
PAST_LEN = 2048

CHUNK = 64
D_MIX = 2 * D_MODEL
SSD_WIDTH = D_MODEL
SSD_HEAD_DIM = 64
SSD_HEADS = SSD_WIDTH // SSD_HEAD_DIM
SSD_GROUPS = 2
SSD_STATE = 128
SSD_CONV_W = 4
SSD_CHUNK = CHUNK
CONV_DIM = SSD_WIDTH + 2 * SSD_GROUPS * SSD_STATE
GMLP_WIDTH = D_MIX - SSD_WIDTH
GMLP_GROUPS = 8
GMLP_GROUP_DIM = GMLP_WIDTH // GMLP_GROUPS
GMLP_CHUNK = 128
D_IN_PROJ = SSD_WIDTH + CONV_DIM + SSD_HEADS + 3 * GMLP_WIDTH
EPS = 1e-6

kernel_name = "hybrid_ssd_gmlp_stream_step"


def rms_norm(x, g):
    xf = x.astype(jnp.float32)
    y = xf * lax.rsqrt(jnp.mean(xf * xf, axis=-1, keepdims=True) + EPS)
    return (y * g.astype(jnp.float32)).astype(x.dtype)


def layer_norm(x, g, b):
    xf = x.astype(jnp.float32)
    mu = jnp.mean(xf, axis=-1, keepdims=True)
    xc = xf - mu
    y = xc * lax.rsqrt(jnp.mean(xc * xc, axis=-1, keepdims=True) + EPS)
    return (y * g.astype(jnp.float32) + b.astype(jnp.float32)).astype(x.dtype)


def causal_conv(xbc, prev, w, b):
    xp = jnp.concatenate([prev.astype(xbc.dtype), xbc], axis=1)
    L = xbc.shape[1]
    out = b
    for k in range(SSD_CONV_W):
        out = out + w[k] * xp[:, k:k + L]
    return jax.nn.silu(out), xp[:, -(SSD_CONV_W - 1):]


def ssd_scan(x, dt, a, bm, cm, h0):
    f32 = jnp.float32
    bsz, L, H, P = x.shape
    G, N = SSD_GROUPS, SSD_STATE
    R = H // G
    lc = min(L, SSD_CHUNK)
    nc = L // lc
    xs = x.astype(f32).reshape(bsz, nc, lc, G, R, P)
    dts = dt.astype(f32).reshape(bsz, nc, lc, G, R)
    bs = bm.astype(f32).reshape(bsz, nc, lc, G, N)
    cs = cm.astype(f32).reshape(bsz, nc, lc, G, N)
    a_cum = jnp.cumsum(dts * a.astype(f32).reshape(G, R), axis=2)
    mask = jnp.tril(jnp.ones((lc, lc), dtype=bool))
    seg = a_cum[:, :, :, None] - a_cum[:, :, None, :]
    decay = jnp.exp(jnp.where(mask[:, :, None, None], seg, -jnp.inf))
    cb = jnp.einsum('bclgn,bcsgn->bclsg', cs, bs)
    w_ls = cb[..., None] * decay * dts[:, :, None]
    y_diag = jnp.einsum('bclsgr,bcsgrp->bclgrp', w_ls, xs)
    decay_end = jnp.exp(a_cum[:, :, -1:] - a_cum)
    chunk_states = jnp.einsum('bclgn,bclgr,bclgrp->bcgrpn', bs, decay_end * dts, xs)
    chunk_decay = jnp.exp(a_cum[:, :, -1])

    def step(h, inp):
        st, dc = inp
        return dc[..., None, None] * h + st, h

    h_init = h0.astype(f32).reshape(bsz, G, R, P, N)
    h_last, h_prev = lax.scan(step, h_init,
                              (jnp.moveaxis(chunk_states, 1, 0), jnp.moveaxis(chunk_decay, 1, 0)))
    h_prev = jnp.moveaxis(h_prev, 0, 1)
    y_off = jnp.einsum('bclgn,bclgr,bcgrpn->bclgrp', cs, jnp.exp(a_cum), h_prev)
    y = (y_diag + y_off).reshape(bsz, L, H, P)
    return y.astype(x.dtype), h_last.reshape(bsz, H, P, N).astype(x.dtype)


def gmlp_spatial(v, w_s, b_s):
    bsz, L, _ = v.shape
    lc = min(L, GMLP_CHUNK)
    nc = L // lc
    vs = v.reshape(bsz, nc, lc, GMLP_GROUPS, GMLP_GROUP_DIM)
    mask = jnp.tril(jnp.ones((lc, lc), dtype=bool))
    w = jnp.where(mask[None], w_s[:, :lc, :lc], 0).astype(v.dtype)
    mixed = jnp.einsum('gts,bnsgd->bntgd', w, vs) + b_s[:, :lc].T[None, None, :, :, None]
    return mixed.reshape(bsz, L, GMLP_WIDTH)


def hybrid_layer(x, c, conv_prev, ssm_prev, w_ada, b_ada, g_pre, g_post, w_in, conv_w, conv_b,
                 dt_bias, a_log, d_skip, g_v, beta_v, w_s, b_s, w_out):
    bsz, L, _ = x.shape
    mod = jax.nn.silu(c) @ w_ada + b_ada
    shift, scale, gate = jnp.split(mod, 3, axis=-1)
    h = rms_norm(x, g_pre) * (1 + scale[:, None]) + shift[:, None]
    proj = h @ w_in
    i1 = SSD_WIDTH
    i2 = i1 + CONV_DIM
    i3 = i2 + SSD_HEADS
    i4 = i3 + GMLP_WIDTH
    i5 = i4 + GMLP_WIDTH
    z, xbc, dt_raw, u, v, gt = jnp.split(proj, [i1, i2, i3, i4, i5], axis=-1)
    xbc, conv_new = causal_conv(xbc, conv_prev, conv_w, conv_b)
    xs, bm, cm = jnp.split(xbc, [SSD_WIDTH, SSD_WIDTH + SSD_GROUPS * SSD_STATE], axis=-1)
    xs = xs.reshape(bsz, L, SSD_HEADS, SSD_HEAD_DIM)
    dt = jax.nn.softplus(dt_raw + dt_bias)
    a = -jnp.exp(a_log.astype(jnp.float32))
    y, ssm_new = ssd_scan(xs, dt, a,
                          bm.reshape(bsz, L, SSD_GROUPS, SSD_STATE),
                          cm.reshape(bsz, L, SSD_GROUPS, SSD_STATE), ssm_prev)
    y = y + d_skip[:, None] * xs
    ssd_out = y.reshape(bsz, L, SSD_WIDTH) * jax.nn.silu(z)
    v_n = layer_norm(v, g_v, beta_v)
    gmlp_out = jax.nn.silu(gt) * u * gmlp_spatial(v_n, w_s, b_s)
    mix = jnp.concatenate([ssd_out, gmlp_out], axis=-1) @ w_out
    out = x + gate[:, None] * rms_norm(mix, g_post)
    return out, conv_new, ssm_new, v_n


def setup_inputs(seed: int = 0) -> dict:
    key = jax.random.key(seed)
    ks = jax.random.split(key, 24)
    f32 = jnp.float32
    nrm = lambda k, s: jax.random.normal(k, s, dtype=f32)
    dt0 = jnp.exp(jax.random.uniform(ks[10], (DEPTH, SSD_HEADS), dtype=f32,
                                     minval=np.log(1e-3), maxval=np.log(1e-1)))
    return {
        "x_prompt": nrm(ks[0], (BATCH, SEQ, D_MODEL)),
        "x_sample": nrm(ks[1], (DEC_BATCH, DEC_SEQ, D_MODEL)),
        "state_conv": nrm(ks[2], (DEPTH, DEC_BATCH, SSD_CONV_W - 1, CONV_DIM)),
        "state_ssm": 0.1 * nrm(ks[3], (DEPTH, DEC_BATCH, SSD_HEADS, SSD_HEAD_DIM, SSD_STATE)),
        "c_prompt": nrm(ks[4], (BATCH, D_MODEL)),
        "c_sample": nrm(ks[5], (DEC_BATCH, D_MODEL)),
        "w_ada": 0.3 * D_MODEL ** -0.5 * nrm(ks[6], (DEPTH, D_MODEL, 3 * D_MODEL)),
        "b_ada": 0.01 * nrm(ks[7], (DEPTH, 3 * D_MODEL)),
        "g_pre": 1.0 + 0.1 * nrm(ks[8], (DEPTH, D_MODEL)),
        "g_post": 1.0 + 0.1 * nrm(ks[9], (DEPTH, D_MODEL)),
        "w_in": D_MODEL ** -0.5 * nrm(ks[11], (DEPTH, D_MODEL, D_IN_PROJ)),
        "conv_w": SSD_CONV_W ** -0.5 * nrm(ks[12], (DEPTH, SSD_CONV_W, CONV_DIM)),
        "conv_b": 0.01 * nrm(ks[13], (DEPTH, CONV_DIM)),
        "dt_bias": dt0 + jnp.log(-jnp.expm1(-dt0)),
        "a_log": jnp.log(jax.random.uniform(ks[14], (DEPTH, SSD_HEADS), dtype=f32, minval=1.0, maxval=16.0)),
        "d_skip": 1.0 + 0.1 * nrm(ks[15], (DEPTH, SSD_HEADS)),
        "g_v": 1.0 + 0.1 * nrm(ks[16], (DEPTH, GMLP_WIDTH)),
        "beta_v": 0.01 * nrm(ks[17], (DEPTH, GMLP_WIDTH)),
        "w_s": GMLP_CHUNK ** -0.5 * nrm(ks[18], (DEPTH, GMLP_GROUPS, GMLP_CHUNK, GMLP_CHUNK)),
        "b_s": 1.0 + 0.1 * nrm(ks[19], (DEPTH, GMLP_GROUPS, GMLP_CHUNK)),
        "w_out": D_MIX ** -0.5 * nrm(ks[20], (DEPTH, D_MIX, D_MODEL)),
    }


def reference(x_prompt, x_sample, state_conv, state_ssm, c_prompt, c_sample, w_ada, b_ada, g_pre,
              g_post, w_in, conv_w, conv_b, dt_bias, a_log, d_skip, g_v, beta_v, w_s, b_s, w_out):
    yp, ys = x_prompt, x_sample
    conv_p_l, ssm_p_l, conv_s_l, ssm_s_l, v_s_l = [], [], [], [], []
    for l in range(DEPTH):
        wl = (w_ada[l], b_ada[l], g_pre[l], g_post[l], w_in[l], conv_w[l], conv_b[l], dt_bias[l],
              a_log[l], d_skip[l], g_v[l], beta_v[l], w_s[l], b_s[l], w_out[l])
        conv0 = jnp.zeros((yp.shape[0], SSD_CONV_W - 1, CONV_DIM), dtype=yp.dtype)
        ssm0 = jnp.zeros((yp.shape[0], SSD_HEADS, SSD_HEAD_DIM, SSD_STATE), dtype=yp.dtype)
        yp, conv_p, ssm_p, _ = hybrid_layer(yp, c_prompt, conv0, ssm0, *wl)
        ys, conv_s, ssm_s, v_s = hybrid_layer(ys, c_sample, state_conv[l], state_ssm[l], *wl)
        conv_p_l.append(conv_p)
        ssm_p_l.append(ssm_p)
        conv_s_l.append(conv_s)
        ssm_s_l.append(ssm_s)
        v_s_l.append(v_s)
    conv_prompt = jnp.stack(conv_p_l)
    ssm_prompt = jnp.stack(ssm_p_l)
    conv_sample = jnp.stack(conv_s_l)
    ssm_sample = jnp.stack(ssm_s_l)
    gmlp_v_sample = jnp.stack(v_s_l)
    return (yp, ys, conv_prompt, ssm_prompt, conv_sample, ssm_sample, gmlp_v_sample)
```

```cpp
#include <hip/hip_runtime.h>
#include <hip/hip_cooperative_groups.h>
#include <cstdio>
#include <cstdint>
namespace cg = cooperative_groups;
namespace pg8 {
#define PG8_LAS __attribute__((address_space(3)))
typedef unsigned short bf16_t;
typedef short bf16x8 __attribute__((ext_vector_type(8)));
typedef float f32x4 __attribute__((ext_vector_type(4)));
typedef unsigned u32x4 __attribute__((ext_vector_type(4)));
constexpr int BM = 256, BK = 64, HALF = 128, HTB = HALF * BK * 2  , STAGE_BYTES = 8 * HTB, NXCD = 8, WGM = 8;

__host__ __device__ __forceinline__ int lds_byte(int r, int c) { const int st = (r >> 4) * 2 + (c >> 5), rr = r & 15, cc = c & 31, ob = rr * 64 + cc * 2; return st * 1024 + (ob ^ (((ob >> 9) & 1) << 5)); }
__host__ __device__ __forceinline__ void stage_rc(int b, int& R, int& C) { const int st = b / 1024, sb = b % 1024, swz = sb ^ (((sb >> 9) & 1) << 5); R = (st >> 1) * 16 + swz / 64; C = (st & 1) * 32 + (swz % 64) / 2; }
__host__ __device__ __forceinline__ int perm32(int rho) { const int n = rho >> 4, i = rho & 15; return 8 * (i >> 2) + 4 * n + (i & 3); }

struct Unit { int pm, pn; };
struct Gemm { const bf16_t* A; const bf16_t* Bt; int M, N, K; };

struct StaticOrder {
    int nM, nN, nwg, G, c;
    __host__ __device__ void init(int M, int N, int G_, int c_) { nM = M / BM; nN = N / BM; nwg = nM * nN; G = G_; c = c_; }
    __host__ __device__ bool next(int i, Unit& u) const {
        const long L = (long)i * G + c; if (L >= nwg) return false;
        int wgid = (int)L; { const int q = nwg / NXCD, r = nwg % NXCD, xcd = wgid % NXCD, off = wgid / NXCD; wgid = (xcd < r ? xcd * (q + 1) : r * (q + 1) + (xcd - r) * q) + off; }
        const int nig = WGM * nN, gid = wgid / nig, fm = gid * WGM, gsz = (nM - fm) < WGM ? (nM - fm) : WGM;
        u.pm = fm + ((wgid % nig) % gsz); u.pn = (wgid % nig) / gsz; return true;
    }
    __device__ __forceinline__ void a_ready(const Unit&) const {}
    __device__ __forceinline__ void done(const Unit&) const {}
};


template <class Epi, class Sched, bool ALIGN_EPI = false, bool SP2 = false>
__device__ __forceinline__ void gemm_phase(PG8_LAS unsigned char* lds, const Gemm g, const Sched& S, const Epi& E) {
    const int tid = threadIdx.x, wid = __builtin_amdgcn_readfirstlane(tid >> 6), lane = tid & 63, wr = wid >> 2, wc = wid & 3, fr = lane & 15, fq = lane >> 4;
    const int K = g.K, nt = K / BK;
    unsigned voffA[2], voffB[2];
#pragma unroll
    for (int i = 0; i < 2; ++i) { int R, C; stage_rc(tid * 16 + i * 8192, R, C); const int Rb = Epi::PERM ? ((R & ~31) + perm32(R & 31)) : R;
        voffA[i] = (unsigned)(R * K + C) * 2u; voffB[i] = (unsigned)(Rb * K + C) * 2u; }
    const size_t kstep = (size_t)(BK * 2);
    const size_t hstep = (size_t)HALF * K * 2;
    const size_t tstep = 2 * hstep;
    const unsigned ldsw = (unsigned)wid * 1024u;
    const int aoff = lds_byte(wr * 64 + fr, fq * 8), boff = lds_byte(wc * 32 + fr, fq * 8);
#define PG8_SA(b, h) (((b) * 2 + (h)) * HTB)
#define PG8_SB(b, h) ((4 + (b) * 2 + (h)) * HTB)
#define PG8_STAGE(bufoff, gbase, voff) do { _Pragma("unroll") for (int _i = 0; _i < 2; ++_i) \
        __builtin_amdgcn_global_load_lds((const unsigned*)((const char*)(gbase) + (voff)[_i]), (PG8_LAS unsigned*)(lds + (bufoff) + ldsw + _i * 8192), 16, 0, 0); } while (0)
#define PG8_LDA(dst, b, h) do { _Pragma("unroll") for (int m = 0; m < 4; ++m) _Pragma("unroll") for (int k = 0; k < 2; ++k) dst[m][k] = *(const PG8_LAS bf16x8*)(lds + PG8_SA(b, h) + aoff + m * 2048 + k * 1024); } while (0)
#define PG8_LDB(dst, b, h) do { _Pragma("unroll") for (int n = 0; n < 2; ++n) _Pragma("unroll") for (int k = 0; k < 2; ++k) dst[n][k] = *(const PG8_LAS bf16x8*)(lds + PG8_SB(b, h) + boff + n * 2048 + k * 1024); } while (0)
#define PG8_MMA(ai, bj, At, Bt) do { __builtin_amdgcn_s_setprio(1); _Pragma("unroll") for (int m = 0; m < 4; ++m) _Pragma("unroll") for (int n = 0; n < 2; ++n) _Pragma("unroll") for (int k = 0; k < 2; ++k) \
        acc[ai][bj][m][n] = __builtin_amdgcn_mfma_f32_16x16x32_bf16(Bt[n][k], At[m][k], acc[ai][bj][m][n], 0, 0, 0); __builtin_amdgcn_s_setprio(0); } while (0)
#define PG8_WAIT_V(n) asm volatile("s_waitcnt vmcnt(" #n ")" ::: "memory")
#define PG8_WAIT_L(n) asm volatile("s_waitcnt lgkmcnt(" #n ")" ::: "memory")
#define PG8_BAR __builtin_amdgcn_s_barrier()
#define PG8_SCHED __builtin_amdgcn_sched_barrier(0)
    Unit cur, nxt; int ui = 0;
    if (!S.next(0, cur)) return;
    f32x4 acc[2][2][4][2];
#pragma unroll
    for (int a = 0; a < 2; ++a)
#pragma unroll
        for (int b = 0; b < 2; ++b)
#pragma unroll
            for (int m = 0; m < 4; ++m)
#pragma unroll
                for (int n = 0; n < 2; ++n) acc[a][b][m][n] = (f32x4){0.f, 0.f, 0.f, 0.f};
    bf16x8 At[4][2], B0[2][2], B1[2][2];
    const char* cA = (const char*)g.A + (size_t)cur.pm * tstep; const char* cB = (const char*)g.Bt + (size_t)cur.pn * tstep;
    S.a_ready(cur);
    if constexpr (SP2) {
        PG8_STAGE(PG8_SB(0, 0), cB, voffB); PG8_STAGE(PG8_SB(0, 1), cB + hstep, voffB); PG8_STAGE(PG8_SA(0, 0), cA, voffA); PG8_STAGE(PG8_SA(0, 1), cA + hstep, voffA);
        if (wr == 1) PG8_BAR;
        PG8_WAIT_V(2); PG8_BAR;
        PG8_STAGE(PG8_SB(1, 0), cB + kstep, voffB); PG8_STAGE(PG8_SA(1, 0), cA + kstep, voffA); PG8_STAGE(PG8_SB(1, 1), cB + hstep + kstep, voffB);
        PG8_WAIT_V(6); PG8_BAR;
    } else {
        PG8_STAGE(PG8_SB(0, 0), cB, voffB); PG8_STAGE(PG8_SA(0, 0), cA, voffA); PG8_STAGE(PG8_SB(0, 1), cB + hstep, voffB); PG8_STAGE(PG8_SA(0, 1), cA + hstep, voffA);
        if (wr == 1) PG8_BAR;
        PG8_WAIT_V(4); PG8_BAR;
        PG8_STAGE(PG8_SB(1, 0), cB + kstep, voffB); PG8_STAGE(PG8_SA(1, 0), cA + kstep, voffA); PG8_STAGE(PG8_SB(1, 1), cB + hstep + kstep, voffB);
        PG8_WAIT_V(6); PG8_BAR;
    }
    for (;;) {
        const bool has_next = S.next(ui + 1, nxt);
        const char* nA = has_next ? (const char*)g.A + (size_t)nxt.pm * tstep : cA; const char* nB = has_next ? (const char*)g.Bt + (size_t)nxt.pn * tstep : cB;
        for (int t = 0; t < nt; t += 2) {
            const bool last = (t == nt - 2);
            const char* a1 = cA + (size_t)(t + 1) * kstep;
            const char* a2 = last ? nA : cA + (size_t)(t + 2) * kstep; const char* b2 = last ? nB : cB + (size_t)(t + 2) * kstep;
            const char* a3 = a2 + kstep; const char* b3 = b2 + kstep;
            if (last && has_next) S.a_ready(nxt);
            if constexpr (SP2) {
            PG8_LDB(B0, 0, 0); PG8_LDB(B1, 0, 1); PG8_SCHED; PG8_LDA(At, 0, 0); PG8_STAGE(PG8_SA(1, 1), a1 + hstep, voffA);
            PG8_WAIT_V(8); PG8_WAIT_L(0); PG8_BAR; PG8_MMA(0, 0, At, B0); PG8_MMA(0, 1, At, B1); PG8_BAR; PG8_SCHED;
            PG8_LDA(At, 0, 1); PG8_STAGE(PG8_SB(0, 0), b2, voffB); PG8_STAGE(PG8_SB(0, 1), b2 + hstep, voffB); PG8_STAGE(PG8_SA(0, 0), a2, voffA);
            PG8_WAIT_V(8); PG8_WAIT_L(0); PG8_BAR; PG8_MMA(1, 0, At, B0); PG8_MMA(1, 1, At, B1); PG8_BAR; PG8_SCHED;
            PG8_LDB(B0, 1, 0); PG8_LDB(B1, 1, 1); PG8_SCHED; PG8_LDA(At, 1, 0); PG8_STAGE(PG8_SA(0, 1), a2 + hstep, voffA);
            PG8_WAIT_V(8); PG8_WAIT_L(0); PG8_BAR; PG8_MMA(0, 0, At, B0); PG8_MMA(0, 1, At, B1); PG8_BAR; PG8_SCHED;
            PG8_LDA(At, 1, 1); PG8_STAGE(PG8_SB(1, 0), b3, voffB); PG8_STAGE(PG8_SB(1, 1), b3 + hstep, voffB); PG8_STAGE(PG8_SA(1, 0), a3, voffA);
            PG8_WAIT_V(8); PG8_WAIT_L(0); PG8_BAR; PG8_MMA(1, 0, At, B0); PG8_MMA(1, 1, At, B1); PG8_BAR; PG8_SCHED;
            } else {
            PG8_LDB(B0, 0, 0); PG8_SCHED; PG8_LDA(At, 0, 0); PG8_STAGE(PG8_SA(1, 1), a1 + hstep, voffA);
            PG8_WAIT_L(8); PG8_BAR; PG8_WAIT_L(0); PG8_MMA(0, 0, At, B0); PG8_BAR; PG8_SCHED;
            PG8_LDB(B1, 0, 1); PG8_STAGE(PG8_SB(0, 0), b2, voffB);
            PG8_BAR; PG8_WAIT_L(0); PG8_MMA(0, 1, At, B1); PG8_BAR;
            PG8_LDA(At, 0, 1); PG8_STAGE(PG8_SA(0, 0), a2, voffA);
            PG8_BAR; PG8_WAIT_L(0); PG8_MMA(1, 0, At, B0); PG8_BAR; PG8_SCHED;
            PG8_STAGE(PG8_SB(0, 1), b2 + hstep, voffB);
            PG8_WAIT_V(6); PG8_BAR; PG8_MMA(1, 1, At, B1); PG8_BAR;
            PG8_LDB(B0, 1, 0); PG8_SCHED; PG8_LDA(At, 1, 0); PG8_STAGE(PG8_SA(0, 1), a2 + hstep, voffA);
            PG8_WAIT_L(8); PG8_BAR; PG8_WAIT_L(0); PG8_MMA(0, 0, At, B0); PG8_BAR; PG8_SCHED;
            PG8_LDB(B1, 1, 1); PG8_STAGE(PG8_SB(1, 0), b3, voffB);
            PG8_BAR; PG8_WAIT_L(0); PG8_MMA(0, 1, At, B1); PG8_BAR;
            PG8_LDA(At, 1, 1); PG8_STAGE(PG8_SA(1, 0), a3, voffA);
            PG8_BAR; PG8_WAIT_L(0); PG8_MMA(1, 0, At, B0); PG8_BAR; PG8_SCHED;
            PG8_STAGE(PG8_SB(1, 1), b3 + hstep, voffB);
            PG8_WAIT_V(6); PG8_BAR; PG8_MMA(1, 1, At, B1); PG8_BAR;
            }
        }
        if constexpr (ALIGN_EPI) { if (wr == 0) PG8_BAR; }
        if constexpr (!Epi::AFTER_DRAIN) { E(acc, cur, wr, wc, fr, fq); S.done(cur); }
        if (!has_next) break;
#pragma unroll
        for (int a = 0; a < 2; ++a)
#pragma unroll
            for (int b = 0; b < 2; ++b)
#pragma unroll
                for (int m = 0; m < 4; ++m)
#pragma unroll
                    for (int n = 0; n < 2; ++n) acc[a][b][m][n] = (f32x4){0.f, 0.f, 0.f, 0.f};
        cur = nxt; cA = nA; cB = nB; ++ui;
        if constexpr (ALIGN_EPI) { if (wr == 1) PG8_BAR; }
    }
    PG8_WAIT_V(0);
    if constexpr (!ALIGN_EPI) { if (wr == 0) PG8_BAR; }
    PG8_BAR;
    if constexpr (Epi::AFTER_DRAIN) { E.fused(acc, cur, wr, wc, fr, fq, lds, wid, lane); S.done(cur); }
#undef PG8_SA
#undef PG8_SB
#undef PG8_STAGE
#undef PG8_LDA
#undef PG8_LDB
#undef PG8_MMA
#undef PG8_WAIT_V
#undef PG8_WAIT_L
#undef PG8_BAR
#undef PG8_SCHED
}
}


#define DI __device__ __forceinline__
#define LAS __attribute__((address_space(3)))
using pg8::bf16_t; using pg8::bf16x8; using pg8::f32x4; using pg8::u32x4;
typedef float f32x16 __attribute__((ext_vector_type(16)));
typedef float f32x2 __attribute__((ext_vector_type(2)));
typedef unsigned u32x2 __attribute__((ext_vector_type(2)));
typedef __bf16 bfv2 __attribute__((ext_vector_type(2)));

constexpr int MP = 32768, MS = 1024, MTOT = 33792, DM = 1024, NPROJ = 5632, NPAD = 5888, NMIX = 2048;
constexpr int XBC0 = 1024, U0 = 2560, V0 = 3584, G0 = 4608;
constexpr float EPS = 1e-6f;
enum { I_XP = 0, I_XS, I_SCONV, I_SSSM, I_CP, I_CS, I_WADA, I_BADA, I_GPRE, I_GPOST, I_WIN, I_CONVW, I_CONVB, I_DTB, I_ALOG, I_DSKIP, I_GV, I_BETAV, I_WS, I_BS, I_WOUT };
constexpr size_t O_Y = 0, O_CONVP = 34603008, O_SSMP = 34621440, O_CONVS = 35145728, O_SSMS = 35293184, O_VS = 39487488, O_END = 40536064;
constexpr size_t OFF_WT1 = 0, OFF_WT2 = 12058624, OFF_MOD = 16252928, OFF_DEC = 16695296, OFF_DT = 16703488, OFF_SLOC = 18866176, OFF_PROJ = 85975040, OFF_MIX = OFF_PROJ,
                 WS_END = OFF_PROJ + (size_t)MTOT * NPROJ * 2;
constexpr int LDS_BYTES = 152 * 1024;

struct Args { const float* in[21]; float* out; unsigned char* ws; int ph_lo, ph_hi; };

DI unsigned pk2(float a, float b) { bfv2 v = __builtin_convertvector((f32x2){a, b}, bfv2); return __builtin_bit_cast(unsigned, v); }
DI float bf_lo(unsigned u) { return __uint_as_float(u << 16); }
DI float bf_hi(unsigned u) { return __uint_as_float(u & 0xffff0000u); }
DI float bf1(bf16_t u) { return __uint_as_float(((unsigned)u) << 16); }
DI bf16_t to_bf(float a) { return (bf16_t)(pk2(a, 0.f) & 0xffffu); }
DI float silu_f(float x) { return x / (1.f + __expf(-x)); }
DI float wave_sum(float v) {
#pragma unroll
    for (int o = 1; o < 64; o <<= 1) v += __shfl_xor(v, o);
    return v;
}
DI int crow(int reg, int h) { return (reg & 3) + 8 * (reg >> 2) + 4 * h; }
DI bf16x8 mk8(unsigned a, unsigned b, unsigned c, unsigned d) { u32x4 p = {a, b, c, d}; return __builtin_bit_cast(bf16x8, p); }
#define MFMA32(a, b, c) __builtin_amdgcn_mfma_f32_32x32x16_bf16((a), (b), (c), 0, 0, 0)
DI void lds_fence() { asm volatile("s_waitcnt lgkmcnt(0)" ::: "memory"); }

struct EpiProj {
    static constexpr bool PERM = true, AFTER_DRAIN = false;
    bf16_t* O; float* DT;
    DI void operator()(const f32x4 (&acc)[2][2][4][2], const pg8::Unit& u, int wr, int wc, int fr, int fq) const {
        const int row0 = u.pm * 256 + wr * 64 + fr;
        if (u.pn < 22) {
            const int col0 = u.pn * 256 + wc * 32 + 8 * fq;
#pragma unroll
            for (int ai = 0; ai < 2; ++ai)
#pragma unroll
                for (int m = 0; m < 4; ++m) { bf16_t* rowp = O + (size_t)(row0 + ai * 128 + m * 16) * NPROJ + col0;
#pragma unroll
                    for (int bj = 0; bj < 2; ++bj) { const f32x4 v0 = acc[ai][bj][m][0], v1 = acc[ai][bj][m][1];
                        u32x4 w; w.x = pk2(v0[0], v0[1]); w.y = pk2(v0[2], v0[3]); w.z = pk2(v1[0], v1[1]); w.w = pk2(v1[2], v1[3]);
                        *(u32x4*)(rowp + bj * 128) = w; } }
        } else if (wc == 0 && fq < 2) {
#pragma unroll
            for (int ai = 0; ai < 2; ++ai)
#pragma unroll
                for (int m = 0; m < 4; ++m) { float* p = DT + (size_t)(row0 + ai * 128 + m * 16) * 16 + 8 * fq;
                    *(f32x4*)p = acc[ai][0][m][0]; *(f32x4*)(p + 4) = acc[ai][0][m][1]; }
        }
    }
};
struct EpiF32 {
    static constexpr bool PERM = false, AFTER_DRAIN = false;
    float* C; int ldc;
    DI void operator()(const f32x4 (&acc)[2][2][4][2], const pg8::Unit& u, int wr, int wc, int fr, int fq) const {
        const int row0 = u.pm * 256 + wr * 64 + fr, col0 = u.pn * 256 + wc * 32 + 4 * fq;
#pragma unroll
        for (int ai = 0; ai < 2; ++ai)
#pragma unroll
            for (int m = 0; m < 4; ++m) { float* rowp = C + (size_t)(row0 + ai * 128 + m * 16) * ldc + col0;
#pragma unroll
                for (int bj = 0; bj < 2; ++bj)
#pragma unroll
                    for (int n = 0; n < 2; ++n) *(f32x4*)(rowp + bj * 128 + n * 16) = acc[ai][bj][m][n]; }
    }
};

DI void transpose_item(const float* W, int N, int src0, int valid, bf16_t* WT, int K, int drow0, int k0, LAS float* scr, int lane) {
    const int c = lane & 31;
#pragma unroll 8
    for (int i = 0; i < 32; ++i) { const int kk = 2 * i + (lane >> 5); float v = 0.f; if (c < valid) v = W[(size_t)(k0 + kk) * N + src0 + c]; scr[kk * 33 + c] = v; }
    lds_fence();
    const int c8 = lane & 7;
#pragma unroll
    for (int j = 0; j < 4; ++j) { const int n = (lane >> 3) + 8 * j; const LAS float* s = scr + (8 * c8) * 33 + n;
        u32x4 o; o.x = pk2(s[0 * 33], s[1 * 33]); o.y = pk2(s[2 * 33], s[3 * 33]); o.z = pk2(s[4 * 33], s[5 * 33]); o.w = pk2(s[6 * 33], s[7 * 33]);
        *(u32x4*)(WT + (size_t)(drow0 + n) * K + k0 + 8 * c8) = o; }
    lds_fence();
}
DI void phase0(const Args& a, LAS unsigned char* lds) {
    const int tid = threadIdx.x, lane = tid & 63, wave = tid >> 6;
    bf16_t* Wt1 = (bf16_t*)(a.ws + OFF_WT1); bf16_t* Wt2 = (bf16_t*)(a.ws + OFF_WT2);
    LAS float* scr = (LAS float*)(lds + wave * 8704);
    const int gw = blockIdx.x * 8 + wave, NGW = gridDim.x * 8;
    constexpr int I1 = 16 * 184, I2 = 32 * 32;
    for (int it = gw; it < I1 + I2; it += NGW) {
        if (it < I1) { const int kb = it / 184, db = it % 184, d0 = db * 32; int src0 = d0, valid = 32;
            if (d0 >= 5632) { src0 = 2560; valid = (d0 == 5632) ? 16 : 0; } else if (d0 >= 2560) src0 = d0 + 16;
            transpose_item(a.in[I_WIN], 5648, src0, valid, Wt1, 1024, d0, kb * 64, scr, lane);
        } else { const int r = it - I1, kb = r >> 5, nb = r & 31; transpose_item(a.in[I_WOUT], 1024, nb * 32, 32, Wt2, 2048, nb * 32, kb * 64, scr, lane); }
    }
    __syncthreads();
    if (blockIdx.x < 96) {
        LAS float* sc = (LAS float*)lds;
        LAS float* red = (LAS float*)(lds + 36864);
        const int c = tid & 31, kq = tid >> 5, n0 = blockIdx.x * 32;
        const float* wada = a.in[I_WADA];
        float acc[36];
#pragma unroll
        for (int r = 0; r < 36; ++r) acc[r] = 0.f;
        for (int kc = 0; kc < 4; ++kc) {
            __syncthreads();
            for (int e = tid; e < 36 * 256; e += 512) { const int r = e >> 8, k = e & 255;
                const float cv = (r < 4) ? a.in[I_CP][r * 1024 + kc * 256 + k] : a.in[I_CS][(r - 4) * 1024 + kc * 256 + k]; sc[e] = silu_f(cv); }
            __syncthreads();
#pragma unroll 4
            for (int j = 0; j < 16; ++j) { const int k = j * 16 + kq; const float wv = wada[(size_t)(kc * 256 + k) * 3072 + n0 + c];
#pragma unroll
                for (int r = 0; r < 36; ++r) acc[r] += sc[r * 256 + k] * wv; }
        }
#pragma unroll
        for (int r = 0; r < 36; ++r) red[(kq * 36 + r) * 32 + c] = acc[r];
        __syncthreads();
        float* mod = (float*)(a.ws + OFF_MOD);
        for (int e = tid; e < 36 * 32; e += 512) { const int r = e >> 5, cc = e & 31; float s = 0.f;
#pragma unroll
            for (int q = 0; q < 16; ++q) s += red[(q * 36 + r) * 32 + cc];
            mod[r * 3072 + n0 + cc] = s + a.in[I_BADA][n0 + cc]; }
    }
}

DI void phase1(const Args& a) {
    const int tid = threadIdx.x, lane = tid & 63, wave = tid >> 6;
    const int gw = blockIdx.x * 8 + wave, NGW = gridDim.x * 8;
    const float* mod = (const float*)(a.ws + OFF_MOD); bf16_t* Hb = (bf16_t*)a.out;
    const f32x4* gp4 = (const f32x4*)a.in[I_GPRE];
    for (int row = gw; row < MTOT; row += NGW) {
        const float* xr; int bi;
        if (row < MP) { xr = a.in[I_XP] + (size_t)row * DM; bi = row >> 13; } else { xr = a.in[I_XS] + (size_t)(row - MP) * DM; bi = 4 + ((row - MP) >> 5); }
        f32x4 v[4]; float ss = 0.f;
#pragma unroll
        for (int j = 0; j < 4; ++j) { v[j] = ((const f32x4*)xr)[lane + 64 * j]; ss += (v[j].x * v[j].x + v[j].y * v[j].y) + (v[j].z * v[j].z + v[j].w * v[j].w); }
        const float rs = rsqrtf(wave_sum(ss) * (1.f / DM) + EPS);
        const f32x4* sh4 = (const f32x4*)(mod + bi * 3072); const f32x4* sc4 = sh4 + 256;
#pragma unroll
        for (int j = 0; j < 4; ++j) { const int k4 = lane + 64 * j; const f32x4 g = gp4[k4], s = sc4[k4], t = sh4[k4];
            const f32x4 hv = v[j] * rs * g * (s + 1.f) + t;
            u32x2 o; o.x = pk2(hv.x, hv.y); o.y = pk2(hv.z, hv.w); *(u32x2*)(Hb + (size_t)row * DM + 4 * k4) = o; }
    }
}

constexpr int L_XT = 0, L_BS = 36864, L_CS = 54272, L_BT = 71680, L_CB = 90112, L_DT = 107520, L_AC = 109568;
constexpr int XT_LD = 72, BS_LD = 136, CB_LD = 68;
constexpr int SCT = 512, NSC = 16;
template <int MODE>
DI void ssd_item(const Args& a, LAS unsigned char* lds, int b, int g, int hq, int sc) {
    constexpr int T = (MODE == 2) ? 32 : 64, NSUB = (MODE == 2) ? 1 : SCT / 64;
    const int tid = threadIdx.x, lane = tid & 63, w = __builtin_amdgcn_readfirstlane(tid >> 6), r = lane & 31, h = lane >> 5;
    const int hl = w >> 1, pbw = w & 1, hh = g * 8 + hq * 4 + hl;
    const bf16_t* PROJ = (const bf16_t*)(a.ws + OFF_PROJ); const float* DTR = (const float*)(a.ws + OFF_DT);
    bf16_t* MIXIN = (bf16_t*)a.out;
    float* SLOC = (float*)(a.ws + OFF_SLOC); float* DEC = (float*)(a.ws + OFF_DEC);
    LAS bf16_t* XT = (LAS bf16_t*)(lds + L_XT); LAS bf16_t* BsL = (LAS bf16_t*)(lds + L_BS); LAS bf16_t* CsL = (LAS bf16_t*)(lds + L_CS);
    LAS bf16_t* BTL = (LAS bf16_t*)(lds + L_BT); LAS float* CBL = (LAS float*)(lds + L_CB);
    LAS float* dtS = (LAS float*)(lds + L_DT) + w * 64; LAS float* acS = (LAS float*)(lds + L_AC) + w * 64;
    const int row0 = (MODE == 2) ? MP + b * 32 : b * 8192 + sc * SCT;
    const float A_h = -__expf(a.in[I_ALOG][hh]), dtb = a.in[I_DTB][hh], Dh = a.in[I_DSKIP][hh];
    const LAS bf16_t* xrow = XT + (hl * 64 + 32 * pbw + r) * XT_LD;

    f32x16 Hs[4];
    if (MODE == 1 && sc > 0) {
        const float* hp = SLOC + (size_t)((b * NSC + sc) * 16 + hh) * 8192 + pbw * 1024 + lane;
#pragma unroll
        for (int nb = 0; nb < 4; ++nb)
#pragma unroll
            for (int i = 0; i < 16; ++i) Hs[nb][i] = hp[nb * 2048 + i * 64];
    } else if (MODE == 2) {
        const float* st = a.in[I_SSSM] + (size_t)(b * 16 + hh) * 8192 + (32 * pbw + r) * 128 + 4 * h;
#pragma unroll
        for (int nb = 0; nb < 4; ++nb)
#pragma unroll
            for (int q = 0; q < 4; ++q) { const f32x4 v = *(const f32x4*)(st + 32 * nb + 8 * q);
                Hs[nb][4 * q] = v.x; Hs[nb][4 * q + 1] = v.y; Hs[nb][4 * q + 2] = v.z; Hs[nb][4 * q + 3] = v.w; }
    } else {
#pragma unroll
        for (int nb = 0; nb < 4; ++nb)
#pragma unroll
            for (int i = 0; i < 16; ++i) Hs[nb][i] = 0.f;
    }

    const int pi = tid & 255, half = tid >> 8;
    int kind, lc, xcol;
    if (pi < 128) { kind = 0; lc = 2 * pi; xcol = g * 512 + hq * 256 + lc; }
    else if (pi < 192) { kind = 1; lc = 2 * (pi - 128); xcol = 1024 + g * 128 + lc; }
    else { kind = 2; lc = 2 * (pi - 192); xcol = 1280 + g * 128 + lc; }
    const bool conv_on = !(MODE == 0 && kind == 2);
    float cw0[4], cw1[4];
#pragma unroll
    for (int k = 0; k < 4; ++k) { cw0[k] = a.in[I_CONVW][k * 1536 + xcol]; cw1[k] = a.in[I_CONVW][k * 1536 + xcol + 1]; }
    const float cb0 = a.in[I_CONVB][xcol], cb1 = a.in[I_CONVB][xcol + 1];
    float dec_total = 0.f;

#pragma unroll 1
    for (int j = 0; j < NSUB; ++j) {
        const int r0 = row0 + 64 * j;
        float acum_end;
        {
            float dtv = 0.f;
            if (lane < T) { const float xr = DTR[(size_t)(r0 + lane) * 16 + hh] + dtb; dtv = (xr > 20.f) ? xr : log1pf(__expf(xr)); }
            float x = A_h * dtv;
#pragma unroll
            for (int o = 1; o < 64; o <<= 1) { const float y = __shfl_up(x, o); if (lane >= o) x += y; }
            dtS[lane] = dtv; acS[lane] = x;
            acum_end = __shfl(x, 63);
        }
        if (conv_on) {
            const int lh = 32 * half;
            float pa[3], pb_[3];
            const bool rows_on = (lh < T);
            if (MODE == 2) {
#pragma unroll
                for (int k = 0; k < 3; ++k) { pa[k] = a.in[I_SCONV][(size_t)(b * 3 + k) * 1536 + xcol]; pb_[k] = a.in[I_SCONV][(size_t)(b * 3 + k) * 1536 + xcol + 1]; }
            } else if (sc == 0 && j == 0 && half == 0) {
#pragma unroll
                for (int k = 0; k < 3; ++k) { pa[k] = 0.f; pb_[k] = 0.f; }
            } else {
#pragma unroll
                for (int k = 0; k < 3; ++k) { const unsigned u = *(const unsigned*)(PROJ + (size_t)(r0 + lh - 3 + k) * NPROJ + XBC0 + xcol); pa[k] = bf_lo(u); pb_[k] = bf_hi(u); }
            }
#pragma unroll 1
            for (int blk = 0; blk < 4; ++blk) {
                const int l0 = lh + 8 * blk;
                float o0[8], o1[8];
                if (rows_on) {
                    unsigned raw[8];
#pragma unroll
                    for (int i = 0; i < 8; ++i) raw[i] = *(const unsigned*)(PROJ + (size_t)(r0 + l0 + i) * NPROJ + XBC0 + xcol);
#pragma unroll
                    for (int i = 0; i < 8; ++i) { const float c0 = bf_lo(raw[i]), c1 = bf_hi(raw[i]);
                        const float v0 = cb0 + cw0[0] * pa[0] + cw0[1] * pa[1] + cw0[2] * pa[2] + cw0[3] * c0;
                        const float v1 = cb1 + cw1[0] * pb_[0] + cw1[1] * pb_[1] + cw1[2] * pb_[2] + cw1[3] * c1;
                        o0[i] = silu_f(v0); o1[i] = silu_f(v1);
                        pa[0] = pa[1]; pa[1] = pa[2]; pa[2] = c0; pb_[0] = pb_[1]; pb_[1] = pb_[2]; pb_[2] = c1; }
                } else {
#pragma unroll
                    for (int i = 0; i < 8; ++i) { o0[i] = 0.f; o1[i] = 0.f; }
                }
                const bf16x8 t0 = mk8(pk2(o0[0], o0[1]), pk2(o0[2], o0[3]), pk2(o0[4], o0[5]), pk2(o0[6], o0[7]));
                const bf16x8 t1 = mk8(pk2(o1[0], o1[1]), pk2(o1[2], o1[3]), pk2(o1[4], o1[5]), pk2(o1[6], o1[7]));
                if (kind == 0) { *(LAS bf16x8*)(XT + lc * XT_LD + l0) = t0; *(LAS bf16x8*)(XT + (lc + 1) * XT_LD + l0) = t1; }
                else if (kind == 1) { *(LAS bf16x8*)(BTL + lc * XT_LD + l0) = t0; *(LAS bf16x8*)(BTL + (lc + 1) * XT_LD + l0) = t1;
                    if (MODE != 0) {
#pragma unroll
                        for (int i = 0; i < 8; ++i) *(LAS unsigned*)(BsL + (l0 + i) * BS_LD + lc) = pk2(o0[i], o1[i]); } }
                else {
#pragma unroll
                    for (int i = 0; i < 8; ++i) *(LAS unsigned*)(CsL + (l0 + i) * BS_LD + lc) = pk2(o0[i], o1[i]); }
            }
        }
        __syncthreads();
        if (MODE != 0) {
            if (w < 4) {
                const int lb = w >> 1, sb = w & 1;
                f32x16 cacc;
#pragma unroll
                for (int i = 0; i < 16; ++i) cacc[i] = 0.f;
#pragma unroll
                for (int ks = 0; ks < 8; ++ks) {
                    const bf16x8 af = *(const LAS bf16x8*)(CsL + (32 * lb + r) * BS_LD + 16 * ks + 8 * h);
                    const bf16x8 bf = *(const LAS bf16x8*)(BsL + (32 * sb + r) * BS_LD + 16 * ks + 8 * h);
                    cacc = MFMA32(af, bf, cacc);
                }
#pragma unroll
                for (int i = 0; i < 16; ++i) CBL[(32 * lb + crow(i, h)) * CB_LD + 32 * sb + r] = cacc[i];
            }
            __syncthreads();
#pragma unroll 1
            for (int lb = 0; lb < T / 32; ++lb) {
                f32x16 Y;
#pragma unroll
                for (int i = 0; i < 16; ++i) Y[i] = 0.f;
                const LAS bf16_t* crow_p = CsL + (32 * lb + r) * BS_LD + 4 * h;
#pragma unroll
                for (int nb = 0; nb < 4; ++nb)
#pragma unroll
                    for (int s = 0; s < 2; ++s) {
                        const u32x2 lo = *(const LAS u32x2*)(crow_p + 32 * nb + 16 * s), hi = *(const LAS u32x2*)(crow_p + 32 * nb + 16 * s + 8);
                        const bf16x8 af = mk8(lo.x, lo.y, hi.x, hi.y);
                        const f32x16& x = Hs[nb];
                        const bf16x8 bfr = mk8(pk2(x[8 * s], x[8 * s + 1]), pk2(x[8 * s + 2], x[8 * s + 3]), pk2(x[8 * s + 4], x[8 * s + 5]), pk2(x[8 * s + 6], x[8 * s + 7]));
                        Y = MFMA32(af, bfr, Y);
                    }
#pragma unroll
                for (int q = 0; q < 4; ++q) { const f32x4 av = *(const LAS f32x4*)(acS + 32 * lb + 8 * q + 4 * h);
#pragma unroll
                    for (int e = 0; e < 4; ++e) Y[4 * q + e] *= __expf(av[e]); }
                const int l = 32 * lb + r; const float al = acS[l];
#pragma unroll 1
                for (int sk = 0; sk < 2 * (lb + 1); ++sk) {
                    const int s0 = 16 * sk + 8 * h;
                    const f32x4 c0 = *(const LAS f32x4*)(CBL + l * CB_LD + s0), c1 = *(const LAS f32x4*)(CBL + l * CB_LD + s0 + 4);
                    const f32x4 a0 = *(const LAS f32x4*)(acS + s0), a1 = *(const LAS f32x4*)(acS + s0 + 4);
                    const f32x4 d0 = *(const LAS f32x4*)(dtS + s0), d1 = *(const LAS f32x4*)(dtS + s0 + 4);
                    float wv[8];
#pragma unroll
                    for (int e = 0; e < 4; ++e) { wv[e] = c0[e] * __expf(al - a0[e]) * d0[e]; wv[4 + e] = c1[e] * __expf(al - a1[e]) * d1[e]; }
#pragma unroll
                    for (int e = 0; e < 8; ++e) { const int s = s0 + e; wv[e] = (s <= l) ? wv[e] : 0.f; if (s == l) wv[e] += Dh; }
                    const bf16x8 af = mk8(pk2(wv[0], wv[1]), pk2(wv[2], wv[3]), pk2(wv[4], wv[5]), pk2(wv[6], wv[7]));
                    const bf16x8 bfr = *(const LAS bf16x8*)(xrow + s0);
                    Y = MFMA32(af, bfr, Y);
                }
                const int col = hh * 64 + 32 * pbw + r;
#pragma unroll
                for (int i = 0; i < 16; ++i) { const size_t row = (size_t)(r0 + 32 * lb + crow(i, h));
                    const float z = bf1(PROJ[row * NPROJ + col]);
                    MIXIN[row * NMIX + col] = to_bf(Y[i] * silu_f(z));
                    if ((i & 3) == 3) asm volatile("" ::: "memory"); }
            }
        }
        {
            const float dA = __expf(acum_end);
#pragma unroll
            for (int nb = 0; nb < 4; ++nb) Hs[nb] = Hs[nb] * dA;
#pragma unroll
            for (int ks = 0; ks < 4; ++ks) {
                const int l0 = 16 * ks + 8 * h;
                const f32x4 a0 = *(const LAS f32x4*)(acS + l0), a1 = *(const LAS f32x4*)(acS + l0 + 4);
                const f32x4 d0 = *(const LAS f32x4*)(dtS + l0), d1 = *(const LAS f32x4*)(dtS + l0 + 4);
                float wl[8];
#pragma unroll
                for (int e = 0; e < 4; ++e) { wl[e] = d0[e] * __expf(acum_end - a0[e]); wl[4 + e] = d1[e] * __expf(acum_end - a1[e]); }
                const u32x4 xr = *(const LAS u32x4*)(xrow + l0);
                const bf16x8 xf = mk8(pk2(bf_lo(xr.x) * wl[0], bf_hi(xr.x) * wl[1]), pk2(bf_lo(xr.y) * wl[2], bf_hi(xr.y) * wl[3]),
                                      pk2(bf_lo(xr.z) * wl[4], bf_hi(xr.z) * wl[5]), pk2(bf_lo(xr.w) * wl[6], bf_hi(xr.w) * wl[7]));
#pragma unroll
                for (int nb = 0; nb < 4; ++nb) {
                    const bf16x8 af = *(const LAS bf16x8*)(BTL + (32 * nb + r) * XT_LD + l0);
                    Hs[nb] = MFMA32(af, xf, Hs[nb]);
                }
            }
            dec_total += acum_end;
        }
        __syncthreads();
    }
    if (MODE == 0) {
        float* hp = SLOC + (size_t)((b * NSC + sc) * 16 + hh) * 8192 + pbw * 1024 + lane;
#pragma unroll
        for (int nb = 0; nb < 4; ++nb)
#pragma unroll
            for (int i = 0; i < 16; ++i) hp[nb * 2048 + i * 64] = Hs[nb][i];
        if (lane == 0 && pbw == 0) DEC[(b * NSC + sc) * 16 + hh] = __expf(dec_total);
    }
    if (MODE == 2) {
        float* st = a.out + O_SSMS + (size_t)(b * 16 + hh) * 8192 + (32 * pbw + r) * 128 + 4 * h;
#pragma unroll
        for (int nb = 0; nb < 4; ++nb)
#pragma unroll
            for (int q = 0; q < 4; ++q) { f32x4 v; v.x = Hs[nb][4 * q]; v.y = Hs[nb][4 * q + 1]; v.z = Hs[nb][4 * q + 2]; v.w = Hs[nb][4 * q + 3];
                *(f32x4*)(st + 32 * nb + 8 * q) = v; }
    }
}

constexpr int VT_LD = 136;
template <bool SAMPLE>
DI void gmlp_item(const Args& a, LAS unsigned char* lds, int item) {
    constexpr int T = SAMPLE ? 32 : 128;
    const int tid = threadIdx.x, lane = tid & 63, w = __builtin_amdgcn_readfirstlane(tid >> 6), r = lane & 31, h = lane >> 5;
    const bf16_t* PROJ = (const bf16_t*)(a.ws + OFF_PROJ); bf16_t* MIXIN = (bf16_t*)a.out;
    const int row0 = SAMPLE ? MP + item * 32 : item * 128;
    LAS float* st = (LAS float*)lds; LAS bf16_t* VT = (LAS bf16_t*)(lds + 1024);
    for (int l = w; l < T; l += 8) {
        const u32x4* vp = (const u32x4*)(PROJ + (size_t)(row0 + l) * NPROJ + V0) + 2 * lane;
        const u32x4 q0 = vp[0], q1 = vp[1];
        float v[16];
        v[0] = bf_lo(q0.x); v[1] = bf_hi(q0.x); v[2] = bf_lo(q0.y); v[3] = bf_hi(q0.y); v[4] = bf_lo(q0.z); v[5] = bf_hi(q0.z); v[6] = bf_lo(q0.w); v[7] = bf_hi(q0.w);
        v[8] = bf_lo(q1.x); v[9] = bf_hi(q1.x); v[10] = bf_lo(q1.y); v[11] = bf_hi(q1.y); v[12] = bf_lo(q1.z); v[13] = bf_hi(q1.z); v[14] = bf_lo(q1.w); v[15] = bf_hi(q1.w);
        float s = 0.f;
#pragma unroll
        for (int i = 0; i < 16; ++i) s += v[i];
        const float mu = wave_sum(s) * (1.f / 1024.f);
        float s2 = 0.f;
#pragma unroll
        for (int i = 0; i < 16; ++i) { const float d = v[i] - mu; s2 += d * d; }
        const float rstd = rsqrtf(wave_sum(s2) * (1.f / 1024.f) + EPS);
        if (lane == 0) { st[2 * l] = mu; st[2 * l + 1] = rstd; }
    }
    __syncthreads();
    for (int gp = 0; gp < 4; ++gp) {
        {
            const int cp = tid & 127, rq = tid >> 7, c0 = gp * 256 + 2 * cp;
            const float gv0 = a.in[I_GV][c0], gv1 = a.in[I_GV][c0 + 1], bv0 = a.in[I_BETAV][c0], bv1 = a.in[I_BETAV][c0 + 1];
#pragma unroll 1
            for (int blk = 0; blk < 4; ++blk) {
                const int l0 = rq * 32 + blk * 8;
                float n0[8], n1[8];
                if (l0 < T) {
                    unsigned raw[8];
#pragma unroll
                    for (int i = 0; i < 8; ++i) raw[i] = *(const unsigned*)(PROJ + (size_t)(row0 + l0 + i) * NPROJ + V0 + c0);
#pragma unroll
                    for (int i = 0; i < 8; ++i) { const float mu = st[2 * (l0 + i)], rs = st[2 * (l0 + i) + 1];
                        n0[i] = (bf_lo(raw[i]) - mu) * rs * gv0 + bv0; n1[i] = (bf_hi(raw[i]) - mu) * rs * gv1 + bv1;
                        if (SAMPLE) { f32x2 o = {n0[i], n1[i]}; *(f32x2*)(a.out + O_VS + (size_t)(item * 32 + l0 + i) * 1024 + c0) = o; } }
                } else {
#pragma unroll
                    for (int i = 0; i < 8; ++i) { n0[i] = 0.f; n1[i] = 0.f; }
                }
                *(LAS bf16x8*)(VT + (2 * cp) * VT_LD + l0) = mk8(pk2(n0[0], n0[1]), pk2(n0[2], n0[3]), pk2(n0[4], n0[5]), pk2(n0[6], n0[7]));
                *(LAS bf16x8*)(VT + (2 * cp + 1) * VT_LD + l0) = mk8(pk2(n1[0], n1[1]), pk2(n1[2], n1[3]), pk2(n1[4], n1[5]), pk2(n1[6], n1[7]));
            }
        }
        __syncthreads();
        {
            const int gi = w >> 2, tq = w & 3, gg = 2 * gp + gi;
            if (32 * tq < T) {
                f32x16 acc[4];
#pragma unroll
                for (int db = 0; db < 4; ++db)
#pragma unroll
                    for (int i = 0; i < 16; ++i) acc[db][i] = 0.f;
                const int t = 32 * tq + r;
                const float* wrow = a.in[I_WS] + (size_t)(gg * 128 + t) * 128;
                for (int ks = 0; ks < 2 * (tq + 1); ++ks) {
                    const int s0 = 16 * ks + 8 * h;
                    const f32x4 w0 = *(const f32x4*)(wrow + s0), w1 = *(const f32x4*)(wrow + s0 + 4);
                    float wv[8] = {w0.x, w0.y, w0.z, w0.w, w1.x, w1.y, w1.z, w1.w};
#pragma unroll
                    for (int e = 0; e < 8; ++e) wv[e] = (s0 + e <= t) ? wv[e] : 0.f;
                    const bf16x8 af = mk8(pk2(wv[0], wv[1]), pk2(wv[2], wv[3]), pk2(wv[4], wv[5]), pk2(wv[6], wv[7]));
#pragma unroll
                    for (int db = 0; db < 4; ++db) {
                        const bf16x8 bfr = *(const LAS bf16x8*)(VT + (gi * 128 + 32 * db + r) * VT_LD + s0);
                        acc[db] = MFMA32(af, bfr, acc[db]);
                    }
                }
#pragma unroll
                for (int i = 0; i < 16; ++i) { const int tt = 32 * tq + crow(i, h);
                    if (tt < T) { const size_t row = (size_t)(row0 + tt); const float bsv = a.in[I_BS][gg * 128 + tt];
#pragma unroll
                        for (int db = 0; db < 4; ++db) { const int d = gg * 128 + 32 * db + r;
                            const float u = bf1(PROJ[row * NPROJ + U0 + d]), gt = bf1(PROJ[row * NPROJ + G0 + d]);
                            MIXIN[row * NMIX + 1024 + d] = to_bf(silu_f(gt) * u * (acc[db][i] + bsv)); } }
                    asm volatile("" ::: "memory"); }
            }
        }
        __syncthreads();
    }
}

DI void phase3(const Args& a, LAS unsigned char* lds) {
    const int bid = blockIdx.x, G = gridDim.x;
#ifndef P3_PART
#define P3_PART 31
#endif
    if (P3_PART & 1) for (int it = bid; it < 256; it += G) { ssd_item<0>(a, lds, it >> 6, (it >> 5) & 1, (it >> 4) & 1, it & 15); __syncthreads(); }
    if (P3_PART & 2) for (int it = bid; it < 256; it += G) { gmlp_item<false>(a, lds, it); __syncthreads(); }
    if (P3_PART & 4) for (int it = bid; it < 128; it += G) { ssd_item<2>(a, lds, it >> 2, (it >> 1) & 1, it & 1, 0); __syncthreads(); }
    if (P3_PART & 8) for (int it = 0; it < 32; ++it) if ((it + 128) % G == bid) { gmlp_item<true>(a, lds, it); __syncthreads(); }
    const bf16_t* PROJ = (const bf16_t*)(a.ws + OFF_PROJ);
    for (int it = 0; it < 36; ++it) if ((it + 160) % G == bid) {
        const size_t rbase = (it < 4) ? (size_t)it * 8192 + 8189 : (size_t)MP + (size_t)(it - 4) * 32 + 29;
        float* o = a.out + ((it < 4) ? O_CONVP + (size_t)it * 4608 : O_CONVS + (size_t)(it - 4) * 4608);
        for (int e = threadIdx.x; e < 4608; e += 512) { const int jj = e / 1536, c = e % 1536; o[e] = bf1(PROJ[(rbase + jj) * NPROJ + XBC0 + c]); }
    }
}
DI void phase4(const Args& a) {
    float* SLOC = (float*)(a.ws + OFF_SLOC); const float* DEC = (const float*)(a.ws + OFF_DEC);
    for (int e = blockIdx.x * 512 + threadIdx.x; e < 131072; e += gridDim.x * 512) {
        const int bh = e >> 11, e4 = e & 2047, b = bh >> 4, head = bh & 15;
        f32x4 S[NSC];
#pragma unroll
        for (int sc = 0; sc < NSC; ++sc) S[sc] = *(const f32x4*)(SLOC + (size_t)((b * NSC + sc) * 16 + head) * 8192 + e4 * 4);
        f32x4 H = {0.f, 0.f, 0.f, 0.f};
#pragma unroll
        for (int sc = 0; sc < NSC; ++sc) { const float d = DEC[(b * NSC + sc) * 16 + head];
            *(f32x4*)(SLOC + (size_t)((b * NSC + sc) * 16 + head) * 8192 + e4 * 4) = H; H = H * d + S[sc]; }
        const int idx = e4 * 4, tile = idx >> 10, i = (idx >> 6) & 15, ln = idx & 63, nb = tile >> 1, pb = tile & 1;
        const int n = 32 * nb + crow(i, ln >> 5), p = 32 * pb + (ln & 31);
        float* o = a.out + O_SSMP + (size_t)((b * 16 + head) * 64 + p) * 128 + n;
        o[0] = H.x; o[128] = H.y; o[256] = H.z; o[384] = H.w;
    }
}
DI void phase5(const Args& a, LAS unsigned char* lds) {
    for (int it = blockIdx.x; it < 256; it += gridDim.x) { ssd_item<1>(a, lds, it >> 6, (it >> 5) & 1, (it >> 4) & 1, it & 15); __syncthreads(); }
}
DI void phase7(const Args& a) {
    const int tid = threadIdx.x, lane = tid & 63, wave = tid >> 6;
    const int gw = blockIdx.x * 8 + wave, NGW = gridDim.x * 8;
    const float* mod = (const float*)(a.ws + OFF_MOD); const float* MIX = (const float*)(a.ws + OFF_MIX);
    const f32x4* gp4 = (const f32x4*)a.in[I_GPOST];
    for (int row = gw; row < MTOT; row += NGW) {
        const float* xr; int bi;
        if (row < MP) { xr = a.in[I_XP] + (size_t)row * DM; bi = row >> 13; } else { xr = a.in[I_XS] + (size_t)(row - MP) * DM; bi = 4 + ((row - MP) >> 5); }
        const f32x4* mr = (const f32x4*)(MIX + (size_t)row * DM);
        f32x4 v[4]; float ss = 0.f;
#pragma unroll
        for (int j = 0; j < 4; ++j) { v[j] = mr[lane + 64 * j]; ss += (v[j].x * v[j].x + v[j].y * v[j].y) + (v[j].z * v[j].z + v[j].w * v[j].w); }
        const float rs = rsqrtf(wave_sum(ss) * (1.f / DM) + EPS);
        const f32x4* gt4 = (const f32x4*)(mod + bi * 3072 + 2048);
#pragma unroll
        for (int j = 0; j < 4; ++j) { const int k4 = lane + 64 * j; const f32x4 x = ((const f32x4*)xr)[k4];
            *(f32x4*)(a.out + O_Y + (size_t)row * DM + 4 * k4) = x + gt4[k4] * (v[j] * rs * gp4[k4]); }
    }
}

#ifndef PH_MASK
#define PH_MASK 0xff
#endif
#define PH_ON(p) (((PH_MASK) >> (p)) & 1)
__global__ __launch_bounds__(512, 2) void fwd(Args a) {
    extern __shared__ __attribute__((aligned(16))) unsigned char shm[];
    LAS unsigned char* lds = (LAS unsigned char*)shm;
    cg::grid_group grid = cg::this_grid();
#define RUN_PHASE(p, ...) if (PH_ON(p) && a.ph_lo <= (p) && (p) < a.ph_hi) { __VA_ARGS__; } if (a.ph_lo <= (p) && (p) + 1 < a.ph_hi) grid.sync();
    RUN_PHASE(0, phase0(a, lds))
    RUN_PHASE(1, phase1(a))
    RUN_PHASE(2, { pg8::Gemm g{(const bf16_t*)a.out, (const bf16_t*)(a.ws + OFF_WT1), MTOT, NPAD, 1024};
            pg8::StaticOrder S; S.init(MTOT, NPAD, (int)gridDim.x, (int)blockIdx.x); EpiProj E{(bf16_t*)(a.ws + OFF_PROJ), (float*)(a.ws + OFF_DT)};
            pg8::gemm_phase<EpiProj, pg8::StaticOrder, true, true>(lds, g, S, E); })
    RUN_PHASE(3, phase3(a, lds))
    RUN_PHASE(4, phase4(a))
    RUN_PHASE(5, phase5(a, lds))
    RUN_PHASE(6, { pg8::Gemm g{(const bf16_t*)a.out, (const bf16_t*)(a.ws + OFF_WT2), MTOT, 1024, 2048};
            pg8::StaticOrder S; S.init(MTOT, 1024, (int)gridDim.x, (int)blockIdx.x); EpiF32 E{(float*)(a.ws + OFF_MIX), 1024};
            pg8::gemm_phase<EpiF32, pg8::StaticOrder, true, true>(lds, g, S, E); })
    if (PH_ON(7) && a.ph_lo <= 7 && 7 < a.ph_hi) phase7(a);
}

#ifndef N_LAUNCHES
#define N_LAUNCHES 1
#endif
extern "C" void kernel_launch(void* const* d_in, const int* in_sizes, int n_in, void* d_out, int out_size, void* d_ws, size_t ws_size, hipStream_t stream) {
    static int grid = 0;
    if (grid == 0) {
        if (n_in != 21 || (size_t)out_size != O_END || ws_size < WS_END) { fprintf(stderr, "kernel_launch: unexpected sizes n_in %d out %d ws %zu (need %zu)\n", n_in, out_size, ws_size, (size_t)WS_END); grid = -1; return; }
        int dev = 0, cus = 0, per_cu = 0;
        if (hipGetDevice(&dev) != hipSuccess || hipDeviceGetAttribute(&cus, hipDeviceAttributeMultiprocessorCount, dev) != hipSuccess) { grid = -1; return; }
        if (hipFuncSetAttribute((const void*)fwd, hipFuncAttributeMaxDynamicSharedMemorySize, LDS_BYTES) != hipSuccess) { fprintf(stderr, "kernel_launch: hipFuncSetAttribute failed\n"); grid = -1; return; }
        if (hipOccupancyMaxActiveBlocksPerMultiprocessor(&per_cu, (const void*)fwd, 512, LDS_BYTES) != hipSuccess || per_cu < 1) { fprintf(stderr, "kernel_launch: occupancy query says %d\n", per_cu); per_cu = 1; }
        (void)hipGetLastError();
        grid = cus;
    }
    if (grid < 0) return;
    Args a{};
    for (int i = 0; i < 21; ++i) a.in[i] = (const float*)d_in[i];
    a.out = (float*)d_out; a.ws = (unsigned char*)d_ws;
    if (N_LAUNCHES == 1) {
        a.ph_lo = 0; a.ph_hi = 8;
        void* args[] = {&a};
        hipError_t e = hipLaunchCooperativeKernel((const void*)fwd, dim3(grid), dim3(512), args, LDS_BYTES, stream);
        if (e != hipSuccess) fprintf(stderr, "kernel_launch: cooperative launch failed: %s (grid %d)\n", hipGetErrorString(e), grid);
    } else {
        for (int ph = 0; ph < 8; ++ph) { a.ph_lo = ph; a.ph_hi = ph + 1; hipLaunchKernelGGL(fwd, dim3(grid), dim3(512), LDS_BYTES, stream, a); }
    }
}
```

```cpp
#include <hip/hip_runtime.h>
#include <hip/hip_cooperative_groups.h>
#include <cstdio>
#include <cstdint>
namespace cg = cooperative_groups;
namespace pg8 {
#define PG8_LAS __attribute__((address_space(3)))
typedef unsigned short bf16_t;
typedef short bf16x8 __attribute__((ext_vector_type(8)));
typedef float f32x4 __attribute__((ext_vector_type(4)));
typedef unsigned u32x4 __attribute__((ext_vector_type(4)));
constexpr int BM = 256, BK = 64, HALF = 128, HTB = HALF * BK * 2  , STAGE_BYTES = 8 * HTB, NXCD = 8, WGM = 8;

__host__ __device__ __forceinline__ int lds_byte(int r, int c) { const int st = (r >> 4) * 2 + (c >> 5), rr = r & 15, cc = c & 31, ob = rr * 64 + cc * 2; return st * 1024 + (ob ^ (((ob >> 9) & 1) << 5)); }
__host__ __device__ __forceinline__ void stage_rc(int b, int& R, int& C) { const int st = b / 1024, sb = b % 1024, swz = sb ^ (((sb >> 9) & 1) << 5); R = (st >> 1) * 16 + swz / 64; C = (st & 1) * 32 + (swz % 64) / 2; }
__host__ __device__ __forceinline__ int perm32(int rho) { const int n = rho >> 4, i = rho & 15; return 8 * (i >> 2) + 4 * n + (i & 3); }

struct Unit { int pm, pn; };
struct Gemm { const bf16_t* A; const bf16_t* Bt; int M, N, K; };

struct StaticOrder {
    int nM, nN, nwg, G, c;
    __host__ __device__ void init(int M, int N, int G_, int c_) { nM = M / BM; nN = N / BM; nwg = nM * nN; G = G_; c = c_; }
    __host__ __device__ bool next(int i, Unit& u) const {
        const long L = (long)i * G + c; if (L >= nwg) return false;
        int wgid = (int)L; { const int q = nwg / NXCD, r = nwg % NXCD, xcd = wgid % NXCD, off = wgid / NXCD; wgid = (xcd < r ? xcd * (q + 1) : r * (q + 1) + (xcd - r) * q) + off; }
        const int nig = WGM * nN, gid = wgid / nig, fm = gid * WGM, gsz = (nM - fm) < WGM ? (nM - fm) : WGM;
        u.pm = fm + ((wgid % nig) % gsz); u.pn = (wgid % nig) / gsz; return true;
    }
    __device__ __forceinline__ void a_ready(const Unit&) const {}
    __device__ __forceinline__ void done(const Unit&) const {}
};


template <class Epi, class Sched, bool ALIGN_EPI = false, bool SP2 = false>
__device__ __forceinline__ void gemm_phase(PG8_LAS unsigned char* lds, const Gemm g, const Sched& S, const Epi& E, const int tid) {
    const int wid = __builtin_amdgcn_readfirstlane(tid >> 6), lane = tid & 63, wr = wid >> 2, wc = wid & 3, fr = lane & 15, fq = lane >> 4;
    const int K = g.K, nt = K / BK;
    unsigned voffA[2], voffB[2];
#pragma unroll
    for (int i = 0; i < 2; ++i) { int R, C; stage_rc(tid * 16 + i * 8192, R, C); const int Rb = Epi::PERM ? ((R & ~31) + perm32(R & 31)) : R;
        voffA[i] = (unsigned)(R * K + C) * 2u; voffB[i] = (unsigned)(Rb * K + C) * 2u; }
    const size_t kstep = (size_t)(BK * 2);
    const size_t hstep = (size_t)HALF * K * 2;
    const size_t tstep = 2 * hstep;
    const unsigned ldsw = (unsigned)wid * 1024u;
    const int aoff = lds_byte(wr * 64 + fr, fq * 8), boff = lds_byte(wc * 32 + fr, fq * 8);
#define PG8_SA(b, h) (((b) * 2 + (h)) * HTB)
#define PG8_SB(b, h) ((4 + (b) * 2 + (h)) * HTB)
#define PG8_STAGE(bufoff, gbase, voff) do { _Pragma("unroll") for (int _i = 0; _i < 2; ++_i) \
        __builtin_amdgcn_global_load_lds((const unsigned*)((const char*)(gbase) + (voff)[_i]), (PG8_LAS unsigned*)(lds + (bufoff) + ldsw + _i * 8192), 16, 0, 0); } while (0)
#define PG8_LDA(dst, b, h) do { _Pragma("unroll") for (int m = 0; m < 4; ++m) _Pragma("unroll") for (int k = 0; k < 2; ++k) dst[m][k] = *(const PG8_LAS bf16x8*)(lds + PG8_SA(b, h) + aoff + m * 2048 + k * 1024); } while (0)
#define PG8_LDB(dst, b, h) do { _Pragma("unroll") for (int n = 0; n < 2; ++n) _Pragma("unroll") for (int k = 0; k < 2; ++k) dst[n][k] = *(const PG8_LAS bf16x8*)(lds + PG8_SB(b, h) + boff + n * 2048 + k * 1024); } while (0)
#define PG8_MMA(ai, bj, At, Bt) do { __builtin_amdgcn_s_setprio(1); _Pragma("unroll") for (int m = 0; m < 4; ++m) _Pragma("unroll") for (int n = 0; n < 2; ++n) _Pragma("unroll") for (int k = 0; k < 2; ++k) \
        acc[ai][bj][m][n] = __builtin_amdgcn_mfma_f32_16x16x32_bf16(Bt[n][k], At[m][k], acc[ai][bj][m][n], 0, 0, 0); __builtin_amdgcn_s_setprio(0); } while (0)
#define PG8_WAIT_V(n) asm volatile("s_waitcnt vmcnt(" #n ")" ::: "memory")
#define PG8_WAIT_L(n) asm volatile("s_waitcnt lgkmcnt(" #n ")" ::: "memory")
#define PG8_BAR __builtin_amdgcn_s_barrier()
#define PG8_SCHED __builtin_amdgcn_sched_barrier(0)
    Unit cur, nxt; int ui = 0;
    if (!S.next(0, cur)) return;
    f32x4 acc[2][2][4][2];
#pragma unroll
    for (int a = 0; a < 2; ++a)
#pragma unroll
        for (int b = 0; b < 2; ++b)
#pragma unroll
            for (int m = 0; m < 4; ++m)
#pragma unroll
                for (int n = 0; n < 2; ++n) acc[a][b][m][n] = (f32x4){0.f, 0.f, 0.f, 0.f};
    bf16x8 At[4][2], B0[2][2], B1[2][2];
    const char* cA = (const char*)g.A + (size_t)cur.pm * tstep; const char* cB = (const char*)g.Bt + (size_t)cur.pn * tstep;
    S.a_ready(cur);
    if constexpr (SP2) {
        PG8_STAGE(PG8_SB(0, 0), cB, voffB); PG8_STAGE(PG8_SB(0, 1), cB + hstep, voffB); PG8_STAGE(PG8_SA(0, 0), cA, voffA); PG8_STAGE(PG8_SA(0, 1), cA + hstep, voffA);
        if (wr == 1) PG8_BAR;
        PG8_WAIT_V(2); PG8_BAR;
        PG8_STAGE(PG8_SB(1, 0), cB + kstep, voffB); PG8_STAGE(PG8_SA(1, 0), cA + kstep, voffA); PG8_STAGE(PG8_SB(1, 1), cB + hstep + kstep, voffB);
        PG8_WAIT_V(6); PG8_BAR;
    } else {
        PG8_STAGE(PG8_SB(0, 0), cB, voffB); PG8_STAGE(PG8_SA(0, 0), cA, voffA); PG8_STAGE(PG8_SB(0, 1), cB + hstep, voffB); PG8_STAGE(PG8_SA(0, 1), cA + hstep, voffA);
        if (wr == 1) PG8_BAR;
        PG8_WAIT_V(4); PG8_BAR;
        PG8_STAGE(PG8_SB(1, 0), cB + kstep, voffB); PG8_STAGE(PG8_SA(1, 0), cA + kstep, voffA); PG8_STAGE(PG8_SB(1, 1), cB + hstep + kstep, voffB);
        PG8_WAIT_V(6); PG8_BAR;
    }
    for (;;) {
        const bool has_next = S.next(ui + 1, nxt);
        const char* nA = has_next ? (const char*)g.A + (size_t)nxt.pm * tstep : cA; const char* nB = has_next ? (const char*)g.Bt + (size_t)nxt.pn * tstep : cB;
        for (int t = 0; t < nt; t += 2) {
            const bool last = (t == nt - 2);
            const char* a1 = cA + (size_t)(t + 1) * kstep;
            const char* a2 = last ? nA : cA + (size_t)(t + 2) * kstep; const char* b2 = last ? nB : cB + (size_t)(t + 2) * kstep;
            const char* a3 = a2 + kstep; const char* b3 = b2 + kstep;
            if (last && has_next) S.a_ready(nxt);
            if constexpr (SP2) {
            PG8_LDB(B0, 0, 0); PG8_LDB(B1, 0, 1); PG8_SCHED; PG8_LDA(At, 0, 0); PG8_STAGE(PG8_SA(1, 1), a1 + hstep, voffA);
            PG8_WAIT_V(8); PG8_WAIT_L(0); PG8_BAR; PG8_MMA(0, 0, At, B0); PG8_MMA(0, 1, At, B1); PG8_BAR; PG8_SCHED;
            PG8_LDA(At, 0, 1); PG8_STAGE(PG8_SB(0, 0), b2, voffB); PG8_STAGE(PG8_SB(0, 1), b2 + hstep, voffB); PG8_STAGE(PG8_SA(0, 0), a2, voffA);
            PG8_WAIT_V(8); PG8_WAIT_L(0); PG8_BAR; PG8_MMA(1, 0, At, B0); PG8_MMA(1, 1, At, B1); PG8_BAR; PG8_SCHED;
            PG8_LDB(B0, 1, 0); PG8_LDB(B1, 1, 1); PG8_SCHED; PG8_LDA(At, 1, 0); PG8_STAGE(PG8_SA(0, 1), a2 + hstep, voffA);
            PG8_WAIT_V(8); PG8_WAIT_L(0); PG8_BAR; PG8_MMA(0, 0, At, B0); PG8_MMA(0, 1, At, B1); PG8_BAR; PG8_SCHED;
            PG8_LDA(At, 1, 1); PG8_STAGE(PG8_SB(1, 0), b3, voffB); PG8_STAGE(PG8_SB(1, 1), b3 + hstep, voffB); PG8_STAGE(PG8_SA(1, 0), a3, voffA);
            PG8_WAIT_V(8); PG8_WAIT_L(0); PG8_BAR; PG8_MMA(1, 0, At, B0); PG8_MMA(1, 1, At, B1); PG8_BAR; PG8_SCHED;
            } else {
            PG8_LDB(B0, 0, 0); PG8_SCHED; PG8_LDA(At, 0, 0); PG8_STAGE(PG8_SA(1, 1), a1 + hstep, voffA);
            PG8_WAIT_L(8); PG8_BAR; PG8_WAIT_L(0); PG8_MMA(0, 0, At, B0); PG8_BAR; PG8_SCHED;
            PG8_LDB(B1, 0, 1); PG8_STAGE(PG8_SB(0, 0), b2, voffB);
            PG8_BAR; PG8_WAIT_L(0); PG8_MMA(0, 1, At, B1); PG8_BAR;
            PG8_LDA(At, 0, 1); PG8_STAGE(PG8_SA(0, 0), a2, voffA);
            PG8_BAR; PG8_WAIT_L(0); PG8_MMA(1, 0, At, B0); PG8_BAR; PG8_SCHED;
            PG8_STAGE(PG8_SB(0, 1), b2 + hstep, voffB);
            PG8_WAIT_V(6); PG8_BAR; PG8_MMA(1, 1, At, B1); PG8_BAR;
            PG8_LDB(B0, 1, 0); PG8_SCHED; PG8_LDA(At, 1, 0); PG8_STAGE(PG8_SA(0, 1), a2 + hstep, voffA);
            PG8_WAIT_L(8); PG8_BAR; PG8_WAIT_L(0); PG8_MMA(0, 0, At, B0); PG8_BAR; PG8_SCHED;
            PG8_LDB(B1, 1, 1); PG8_STAGE(PG8_SB(1, 0), b3, voffB);
            PG8_BAR; PG8_WAIT_L(0); PG8_MMA(0, 1, At, B1); PG8_BAR;
            PG8_LDA(At, 1, 1); PG8_STAGE(PG8_SA(1, 0), a3, voffA);
            PG8_BAR; PG8_WAIT_L(0); PG8_MMA(1, 0, At, B0); PG8_BAR; PG8_SCHED;
            PG8_STAGE(PG8_SB(1, 1), b3 + hstep, voffB);
            PG8_WAIT_V(6); PG8_BAR; PG8_MMA(1, 1, At, B1); PG8_BAR;
            }
        }
        if constexpr (ALIGN_EPI) { if (wr == 0) PG8_BAR; }
        if constexpr (!Epi::AFTER_DRAIN) { E(acc, cur, wr, wc, fr, fq); S.done(cur); }
        if (!has_next) break;
#pragma unroll
        for (int a = 0; a < 2; ++a)
#pragma unroll
            for (int b = 0; b < 2; ++b)
#pragma unroll
                for (int m = 0; m < 4; ++m)
#pragma unroll
                    for (int n = 0; n < 2; ++n) acc[a][b][m][n] = (f32x4){0.f, 0.f, 0.f, 0.f};
        cur = nxt; cA = nA; cB = nB; ++ui;
        if constexpr (ALIGN_EPI) { if (wr == 1) PG8_BAR; }
    }
    PG8_WAIT_V(0);
    if constexpr (!ALIGN_EPI) { if (wr == 0) PG8_BAR; }
    PG8_BAR;
    if constexpr (Epi::AFTER_DRAIN) { E.fused(acc, cur, wr, wc, fr, fq, lds, wid, lane); S.done(cur); }
#undef PG8_SA
#undef PG8_SB
#undef PG8_STAGE
#undef PG8_LDA
#undef PG8_LDB
#undef PG8_MMA
#undef PG8_WAIT_V
#undef PG8_WAIT_L
#undef PG8_BAR
#undef PG8_SCHED
}
}


#define DI __device__ __forceinline__
#define LAS __attribute__((address_space(3)))
using pg8::bf16_t; using pg8::bf16x8; using pg8::f32x4; using pg8::u32x4;
typedef float f32x16 __attribute__((ext_vector_type(16)));
typedef float f32x2 __attribute__((ext_vector_type(2)));
typedef unsigned u32x2 __attribute__((ext_vector_type(2)));
typedef __bf16 bfv2 __attribute__((ext_vector_type(2)));

constexpr int MP = 32768, MS = 1024, MTOT = 33792, DM = 1024, NPROJ = 5632, NPAD = 5888, NMIX = 2048;
constexpr int XBC0 = 1024, U0 = 2560, V0 = 3584, G0 = 4608;
constexpr float EPS = 1e-6f;
enum { I_XP = 0, I_XS, I_SCONV, I_SSSM, I_CP, I_CS, I_WADA, I_BADA, I_GPRE, I_GPOST, I_WIN, I_CONVW, I_CONVB, I_DTB, I_ALOG, I_DSKIP, I_GV, I_BETAV, I_WS, I_BS, I_WOUT };
constexpr size_t O_Y = 0, O_CONVP = 34603008, O_SSMP = 34621440, O_CONVS = 35145728, O_SSMS = 35293184, O_VS = 39487488, O_END = 40536064;
constexpr size_t OFF_WT1 = 0, OFF_WT2 = 12058624, OFF_MOD = 16252928, OFF_DEC = 16695296, OFF_DT = 16703488, OFF_SLOC = 18866176, OFF_PROJ = 85975040, OFF_MIX = OFF_PROJ,
                 WS_END = OFF_PROJ + (size_t)MTOT * NPROJ * 2;
constexpr int LDS_BYTES = 152 * 1024;

struct Args { const float* in[21]; float* out; unsigned char* ws; int ph_lo, ph_hi; };
struct DArgs : Args { int wave_s; };
DI int my_tid(const DArgs& a) { return a.wave_s * 64 + (int)__builtin_amdgcn_mbcnt_hi(~0u, __builtin_amdgcn_mbcnt_lo(~0u, 0u)); }

DI unsigned pk2(float a, float b) { bfv2 v = __builtin_convertvector((f32x2){a, b}, bfv2); return __builtin_bit_cast(unsigned, v); }
DI float bf_lo(unsigned u) { return __uint_as_float(u << 16); }
DI float bf_hi(unsigned u) { return __uint_as_float(u & 0xffff0000u); }
DI float bf1(bf16_t u) { return __uint_as_float(((unsigned)u) << 16); }
DI bf16_t to_bf(float a) { return (bf16_t)(pk2(a, 0.f) & 0xffffu); }
DI float silu_f(float x) { return x * __builtin_amdgcn_rcpf(1.f + __expf(-x)); }
DI float wave_sum(float v) {
#pragma unroll
    for (int o = 1; o < 64; o <<= 1) v += __shfl_xor(v, o);
    return v;
}
DI int crow(int reg, int h) { return (reg & 3) + 8 * (reg >> 2) + 4 * h; }
DI bf16x8 mk8(unsigned a, unsigned b, unsigned c, unsigned d) { u32x4 p = {a, b, c, d}; return __builtin_bit_cast(bf16x8, p); }
#define MFMA32(a, b, c) __builtin_amdgcn_mfma_f32_32x32x16_bf16((a), (b), (c), 0, 0, 0)
DI void lds_fence() { asm volatile("s_waitcnt lgkmcnt(0)" ::: "memory"); }

struct EpiProj {
    static constexpr bool PERM = true, AFTER_DRAIN = false;
    bf16_t* O; float* DT;
    DI void operator()(const f32x4 (&acc)[2][2][4][2], const pg8::Unit& u, int wr, int wc, int fr, int fq) const {
        const int row0 = u.pm * 256 + wr * 64 + fr;
        if (u.pn < 22) {
            const int col0 = u.pn * 256 + wc * 32 + 8 * fq;
#pragma unroll
            for (int ai = 0; ai < 2; ++ai)
#pragma unroll
                for (int m = 0; m < 4; ++m) { bf16_t* rowp = O + (size_t)(row0 + ai * 128 + m * 16) * NPROJ + col0;
#pragma unroll
                    for (int bj = 0; bj < 2; ++bj) { const f32x4 v0 = acc[ai][bj][m][0], v1 = acc[ai][bj][m][1];
                        u32x4 w; w.x = pk2(v0[0], v0[1]); w.y = pk2(v0[2], v0[3]); w.z = pk2(v1[0], v1[1]); w.w = pk2(v1[2], v1[3]);
                        *(u32x4*)(rowp + bj * 128) = w; } }
        } else if (wc == 0 && fq < 2) {
#pragma unroll
            for (int ai = 0; ai < 2; ++ai)
#pragma unroll
                for (int m = 0; m < 4; ++m) { float* p = DT + (size_t)(row0 + ai * 128 + m * 16) * 16 + 8 * fq;
                    *(f32x4*)p = acc[ai][0][m][0]; *(f32x4*)(p + 4) = acc[ai][0][m][1]; }
        }
    }
};
struct EpiF32 {
    static constexpr bool PERM = false, AFTER_DRAIN = false;
    float* C; int ldc;
    DI void operator()(const f32x4 (&acc)[2][2][4][2], const pg8::Unit& u, int wr, int wc, int fr, int fq) const {
        const int row0 = u.pm * 256 + wr * 64 + fr, col0 = u.pn * 256 + wc * 32 + 4 * fq;
#pragma unroll
        for (int ai = 0; ai < 2; ++ai)
#pragma unroll
            for (int m = 0; m < 4; ++m) { float* rowp = C + (size_t)(row0 + ai * 128 + m * 16) * ldc + col0;
#pragma unroll
                for (int bj = 0; bj < 2; ++bj)
#pragma unroll
                    for (int n = 0; n < 2; ++n) *(f32x4*)(rowp + bj * 128 + n * 16) = acc[ai][bj][m][n]; }
    }
};

DI void transpose_item(const float* W, int N, int src0, int valid, bf16_t* WT, int K, int drow0, int k0, LAS float* scr, int lane) {
    const int c = lane & 31;
#pragma unroll 8
    for (int i = 0; i < 32; ++i) { const int kk = 2 * i + (lane >> 5); float v = 0.f; if (c < valid) v = W[(size_t)(k0 + kk) * N + src0 + c]; scr[kk * 33 + c] = v; }
    lds_fence();
    const int c8 = lane & 7;
#pragma unroll
    for (int j = 0; j < 4; ++j) { const int n = (lane >> 3) + 8 * j; const LAS float* s = scr + (8 * c8) * 33 + n;
        u32x4 o; o.x = pk2(s[0 * 33], s[1 * 33]); o.y = pk2(s[2 * 33], s[3 * 33]); o.z = pk2(s[4 * 33], s[5 * 33]); o.w = pk2(s[6 * 33], s[7 * 33]);
        *(u32x4*)(WT + (size_t)(drow0 + n) * K + k0 + 8 * c8) = o; }
    lds_fence();
}
DI void phase0(const DArgs& a, LAS unsigned char* lds) {
    const int tid = my_tid(a), lane = tid & 63, wave = tid >> 6;
    bf16_t* Wt1 = (bf16_t*)(a.ws + OFF_WT1); bf16_t* Wt2 = (bf16_t*)(a.ws + OFF_WT2);
    LAS float* scr = (LAS float*)(lds + wave * 8704);
    const int gw = blockIdx.x * 8 + wave, NGW = gridDim.x * 8;
    constexpr int I1 = 16 * 184, I2 = 32 * 32;
    for (int it = gw; it < I1 + I2; it += NGW) {
        if (it < I1) { const int kb = it / 184, db = it % 184, d0 = db * 32; int src0 = d0, valid = 32;
            if (d0 >= 5632) { src0 = 2560; valid = (d0 == 5632) ? 16 : 0; } else if (d0 >= 2560) src0 = d0 + 16;
            transpose_item(a.in[I_WIN], 5648, src0, valid, Wt1, 1024, d0, kb * 64, scr, lane);
        } else { const int r = it - I1, kb = r >> 5, nb = r & 31; transpose_item(a.in[I_WOUT], 1024, nb * 32, 32, Wt2, 2048, nb * 32, kb * 64, scr, lane); }
    }
    __syncthreads();
    if (blockIdx.x < 96) {
        LAS float* sc = (LAS float*)lds;
        LAS float* red = (LAS float*)(lds + 36864);
        const int c4 = tid & 7, rg = (tid >> 3) & 3, kq = tid >> 5, n0 = blockIdx.x * 32;
        const float* wada = a.in[I_WADA];
        f32x4 acc[9];
#pragma unroll
        for (int r = 0; r < 9; ++r) acc[r] = (f32x4){0.f, 0.f, 0.f, 0.f};
        for (int kc = 0; kc < 4; ++kc) {
            __syncthreads();
            for (int e = tid; e < 36 * 256; e += 512) { const int r = e >> 8, k = e & 255;
                const float cv = (r < 4) ? a.in[I_CP][r * 1024 + kc * 256 + k] : a.in[I_CS][(r - 4) * 1024 + kc * 256 + k]; sc[e] = silu_f(cv); }
            __syncthreads();
            f32x4 wv[4][4];
#pragma unroll
            for (int j = 0; j < 4; ++j)
#pragma unroll
                for (int q = 0; q < 4; ++q) wv[j][q] = *(const f32x4*)(wada + (size_t)(kc * 256 + 4 * (kq + 16 * j) + q) * 3072 + n0 + 4 * c4);
#pragma unroll
            for (int j = 0; j < 4; ++j)
#pragma unroll
                for (int r = 0; r < 9; ++r) { const f32x4 s = *(const LAS f32x4*)(sc + (rg * 9 + r) * 256 + 4 * (kq + 16 * j));
                    acc[r] += wv[j][0] * s.x + wv[j][1] * s.y + wv[j][2] * s.z + wv[j][3] * s.w; }
        }
#pragma unroll
        for (int r = 0; r < 9; ++r) *(LAS f32x4*)(red + (kq * 36 + rg * 9 + r) * 32 + 4 * c4) = acc[r];
        __syncthreads();
        float* mod = (float*)(a.ws + OFF_MOD);
        for (int e = tid; e < 36 * 32; e += 512) { const int r = e >> 5, cc = e & 31; float s = 0.f;
#pragma unroll
            for (int q = 0; q < 16; ++q) s += red[(q * 36 + r) * 32 + cc];
            mod[r * 3072 + n0 + cc] = s + a.in[I_BADA][n0 + cc]; }
    }
}

DI void phase1(const DArgs& a) {
    const int tid = my_tid(a), lane = tid & 63, wave = tid >> 6;
    const int gw = blockIdx.x * 8 + wave, NGW = gridDim.x * 8;
    const float* mod = (const float*)(a.ws + OFF_MOD); bf16_t* Hb = (bf16_t*)a.out;
    const f32x4* gp4 = (const f32x4*)a.in[I_GPRE];
    for (int row = gw; row < MTOT; row += NGW) {
        const float* xr; int bi;
        if (row < MP) { xr = a.in[I_XP] + (size_t)row * DM; bi = row >> 13; } else { xr = a.in[I_XS] + (size_t)(row - MP) * DM; bi = 4 + ((row - MP) >> 5); }
        f32x4 v[4]; float ss = 0.f;
#pragma unroll
        for (int j = 0; j < 4; ++j) { v[j] = ((const f32x4*)xr)[lane + 64 * j]; ss += (v[j].x * v[j].x + v[j].y * v[j].y) + (v[j].z * v[j].z + v[j].w * v[j].w); }
        const float rs = rsqrtf(wave_sum(ss) * (1.f / DM) + EPS);
        const f32x4* sh4 = (const f32x4*)(mod + bi * 3072); const f32x4* sc4 = sh4 + 256;
#pragma unroll
        for (int j = 0; j < 4; ++j) { const int k4 = lane + 64 * j; const f32x4 g = gp4[k4], s = sc4[k4], t = sh4[k4];
            const f32x4 hv = v[j] * rs * g * (s + 1.f) + t;
            u32x2 o; o.x = pk2(hv.x, hv.y); o.y = pk2(hv.z, hv.w); *(u32x2*)(Hb + (size_t)row * DM + 4 * k4) = o; }
    }
}

constexpr int L_XT = 0, L_BS = 36864, L_CS = 54272, L_BT = 71680, L_CB = 90112, L_DT = 107520, L_AC = 109568;
constexpr int XT_LD = 72, BS_LD = 136, CB_LD = 68;
constexpr int SCT = 512, NSC = 16;
template <int MODE>
DI void ssd_item(const DArgs& a, LAS unsigned char* lds, int b, int g, int hq, int sc) {
    constexpr int T = (MODE == 2) ? 32 : 64, NSUB = (MODE == 2) ? 1 : SCT / 64;
    int tid = my_tid(a); asm volatile("" : "+v"(tid));
    const int lane = tid & 63, w = __builtin_amdgcn_readfirstlane(tid >> 6), r = lane & 31, h = lane >> 5;
    const int hl = w >> 1, pbw = w & 1, hh = g * 8 + hq * 4 + hl;
    const bf16_t* PROJ = (const bf16_t*)(a.ws + OFF_PROJ); const float* DTR = (const float*)(a.ws + OFF_DT);
    bf16_t* MIXIN = (bf16_t*)a.out;
    float* SLOC = (float*)(a.ws + OFF_SLOC); float* DEC = (float*)(a.ws + OFF_DEC);
    LAS bf16_t* XT = (LAS bf16_t*)(lds + L_XT); LAS bf16_t* BsL = (LAS bf16_t*)(lds + L_BS); LAS bf16_t* CsL = (LAS bf16_t*)(lds + L_CS);
    LAS bf16_t* BTL = (LAS bf16_t*)(lds + L_BT); LAS float* CBL = (LAS float*)(lds + L_CB);
    LAS float* dtS = (LAS float*)(lds + L_DT) + w * 64; LAS float* acS = (LAS float*)(lds + L_AC) + w * 64;
    const int row0 = (MODE == 2) ? MP + b * 32 : b * 8192 + sc * SCT;
    const float A_h = -__expf(a.in[I_ALOG][hh]), dtb = a.in[I_DTB][hh], Dh = a.in[I_DSKIP][hh];
    const LAS bf16_t* xrow = XT + (hl * 64 + 32 * pbw + r) * XT_LD;

    f32x16 Hs[4];
    if (MODE == 1 && sc > 0) {
        const float* hp = SLOC + (size_t)((b * NSC + sc) * 16 + hh) * 8192 + pbw * 1024 + lane;
#pragma unroll
        for (int nb = 0; nb < 4; ++nb)
#pragma unroll
            for (int i = 0; i < 16; ++i) Hs[nb][i] = hp[nb * 2048 + i * 64];
    } else if (MODE == 2) {
        const float* st = a.in[I_SSSM] + (size_t)(b * 16 + hh) * 8192 + (32 * pbw + r) * 128 + 4 * h;
#pragma unroll
        for (int nb = 0; nb < 4; ++nb)
#pragma unroll
            for (int q = 0; q < 4; ++q) { const f32x4 v = *(const f32x4*)(st + 32 * nb + 8 * q);
                Hs[nb][4 * q] = v.x; Hs[nb][4 * q + 1] = v.y; Hs[nb][4 * q + 2] = v.z; Hs[nb][4 * q + 3] = v.w; }
    } else {
#pragma unroll
        for (int nb = 0; nb < 4; ++nb)
#pragma unroll
            for (int i = 0; i < 16; ++i) Hs[nb][i] = 0.f;
    }

    asm volatile("" ::: "memory");
    const int pi = tid & 255, half = tid >> 8;
    int kind, lc, xcol;
    if (pi < 128) { kind = 0; lc = 2 * pi; xcol = g * 512 + hq * 256 + lc; }
    else if (pi < 192) { kind = 1; lc = 2 * (pi - 128); xcol = 1024 + g * 128 + lc; }
    else { kind = 2; lc = 2 * (pi - 192); xcol = 1280 + g * 128 + lc; }
    const bool conv_on = !(MODE == 0 && kind == 2);
    float cw0[4], cw1[4];
#pragma unroll
    for (int k = 0; k < 4; ++k) { cw0[k] = a.in[I_CONVW][k * 1536 + xcol]; cw1[k] = a.in[I_CONVW][k * 1536 + xcol + 1]; }
    const float cb0 = a.in[I_CONVB][xcol], cb1 = a.in[I_CONVB][xcol + 1];
    float dec_total = 0.f;
    asm volatile("" ::: "memory");
    const int lh = 32 * half;
    const bool rows_on = (lh < T);
#define SSD_ISSUE(jn) do { const int rr = row0 + 64 * (jn) + lh; \
        if (conv_on && rows_on) { \
            if (MODE != 2) { _Pragma("unroll") for (int k = 0; k < 3; ++k) { int rw = rr - 3 + k; rw = rw < 0 ? 0 : rw; win[k] = *(const unsigned*)(PROJ + (size_t)rw * NPROJ + XBC0 + xcol); } } \
            _Pragma("unroll") for (int i = 0; i < 32; ++i) raw[i] = *(const unsigned*)(PROJ + (size_t)(rr + i) * NPROJ + XBC0 + xcol); } \
        dtn = (lane < T) ? DTR[(size_t)(row0 + 64 * (jn)) * 16 + lane * 16 + hh] : 0.f; } while (0)

#pragma unroll 1
    for (int j = 0; j < NSUB; ++j) {
        const int r0 = row0 + 64 * j;
        int tid_o = tid; asm volatile("" : "+v"(tid_o));
        const int lane = tid_o & 63, r = lane & 31, h = lane >> 5;
        const LAS bf16_t* xrow = XT + (hl * 64 + 32 * pbw + r) * XT_LD;
        unsigned win[3], raw[32]; float dtn = 0.f;
#pragma unroll
        for (int k = 0; k < 3; ++k) win[k] = 0u;
#pragma unroll
        for (int i = 0; i < 32; ++i) raw[i] = 0u;
        SSD_ISSUE(j);
        float acum_end;
        {
            float dtv = 0.f;
            if (lane < T) { const float xr = dtn + dtb; dtv = (xr > 20.f) ? xr : log1pf(__expf(xr)); }
            float x = A_h * dtv;
#pragma unroll
            for (int o = 1; o < 64; o <<= 1) { const float y = __shfl_up(x, o); if (lane >= o) x += y; }
            dtS[lane] = dtv; acS[lane] = x;
            acum_end = __shfl(x, 63);
        }
        if (conv_on) {
            float pa[3], pb_[3];
            if (MODE == 2) {
#pragma unroll
                for (int k = 0; k < 3; ++k) { pa[k] = a.in[I_SCONV][(size_t)(b * 3 + k) * 1536 + xcol]; pb_[k] = a.in[I_SCONV][(size_t)(b * 3 + k) * 1536 + xcol + 1]; }
            } else {
                const bool zero_win = (sc == 0 && j == 0 && half == 0);
#pragma unroll
                for (int k = 0; k < 3; ++k) { pa[k] = zero_win ? 0.f : bf_lo(win[k]); pb_[k] = zero_win ? 0.f : bf_hi(win[k]); }
            }
#pragma unroll
            for (int blk = 0; blk < 4; ++blk) {
                const int l0 = lh + 8 * blk;
                float o0[8], o1[8];
#pragma unroll
                for (int i = 0; i < 8; ++i) { const float c0 = bf_lo(raw[8 * blk + i]), c1 = bf_hi(raw[8 * blk + i]);
                    const float v0 = cb0 + cw0[0] * pa[0] + cw0[1] * pa[1] + cw0[2] * pa[2] + cw0[3] * c0;
                    const float v1 = cb1 + cw1[0] * pb_[0] + cw1[1] * pb_[1] + cw1[2] * pb_[2] + cw1[3] * c1;
                    o0[i] = rows_on ? silu_f(v0) : 0.f; o1[i] = rows_on ? silu_f(v1) : 0.f;
                    pa[0] = pa[1]; pa[1] = pa[2]; pa[2] = c0; pb_[0] = pb_[1]; pb_[1] = pb_[2]; pb_[2] = c1; }
                const bf16x8 t0 = mk8(pk2(o0[0], o0[1]), pk2(o0[2], o0[3]), pk2(o0[4], o0[5]), pk2(o0[6], o0[7]));
                const bf16x8 t1 = mk8(pk2(o1[0], o1[1]), pk2(o1[2], o1[3]), pk2(o1[4], o1[5]), pk2(o1[6], o1[7]));
                if (kind == 0) { *(LAS bf16x8*)(XT + lc * XT_LD + l0) = t0; *(LAS bf16x8*)(XT + (lc + 1) * XT_LD + l0) = t1; }
                else if (kind == 1) { *(LAS bf16x8*)(BTL + lc * XT_LD + l0) = t0; *(LAS bf16x8*)(BTL + (lc + 1) * XT_LD + l0) = t1;
                    if (MODE != 0) {
#pragma unroll
                        for (int i = 0; i < 8; ++i) *(LAS unsigned*)(BsL + (l0 + i) * BS_LD + lc) = pk2(o0[i], o1[i]); } }
                else {
#pragma unroll
                    for (int i = 0; i < 8; ++i) *(LAS unsigned*)(CsL + (l0 + i) * BS_LD + lc) = pk2(o0[i], o1[i]); }
            }
        }
        unsigned zz[16];
        if (MODE != 0) {
            const int col = hh * 64 + 32 * pbw + r;
            const bf16_t* zp = PROJ + (size_t)r0 * NPROJ; const unsigned zoff = (unsigned)(4 * h) * NPROJ + col;
#pragma unroll
            for (int i = 0; i < 16; ++i) { const unsigned lo = zp[zoff + (unsigned)crow(i, 0) * NPROJ];
                const unsigned hi = (T > 32) ? (unsigned)zp[zoff + (unsigned)(32 + crow(i, 0)) * NPROJ] : 0u;
                zz[i] = lo | (hi << 16); }
        }
        __syncthreads();
        if (MODE != 0) {
            if (w < 4) {
                const int lb = w >> 1, sb = w & 1;
                f32x16 cacc;
#pragma unroll
                for (int i = 0; i < 16; ++i) cacc[i] = 0.f;
#pragma unroll
                for (int ks = 0; ks < 8; ++ks) {
                    const bf16x8 af = *(const LAS bf16x8*)(CsL + (32 * lb + r) * BS_LD + 16 * ks + 8 * h);
                    const bf16x8 bf = *(const LAS bf16x8*)(BsL + (32 * sb + r) * BS_LD + 16 * ks + 8 * h);
                    cacc = MFMA32(af, bf, cacc);
                }
#pragma unroll
                for (int i = 0; i < 16; ++i) CBL[(32 * lb + crow(i, h)) * CB_LD + 32 * sb + r] = cacc[i];
            }
            __syncthreads();
#pragma unroll 1
            for (int lb = 0; lb < T / 32; ++lb) {
                f32x16 Y;
#pragma unroll
                for (int i = 0; i < 16; ++i) Y[i] = 0.f;
                const LAS bf16_t* crow_p = CsL + (32 * lb + r) * BS_LD + 4 * h;
#pragma unroll
                for (int nb = 0; nb < 4; ++nb)
#pragma unroll
                    for (int s = 0; s < 2; ++s) {
                        const u32x2 lo = *(const LAS u32x2*)(crow_p + 32 * nb + 16 * s), hi = *(const LAS u32x2*)(crow_p + 32 * nb + 16 * s + 8);
                        const bf16x8 af = mk8(lo.x, lo.y, hi.x, hi.y);
                        const f32x16& x = Hs[nb];
                        const bf16x8 bfr = mk8(pk2(x[8 * s], x[8 * s + 1]), pk2(x[8 * s + 2], x[8 * s + 3]), pk2(x[8 * s + 4], x[8 * s + 5]), pk2(x[8 * s + 6], x[8 * s + 7]));
                        Y = MFMA32(af, bfr, Y);
                        if (s == 1) asm volatile("" ::: "memory");
                    }
#pragma unroll
                for (int q = 0; q < 4; ++q) { const f32x4 av = *(const LAS f32x4*)(acS + 32 * lb + 8 * q + 4 * h);
#pragma unroll
                    for (int e = 0; e < 4; ++e) Y[4 * q + e] *= __expf(av[e]); }
                const int l = 32 * lb + r; const float al = acS[l];
#pragma unroll 1
                for (int sk = 0; sk < 2 * (lb + 1); ++sk) {
                    const int s0 = 16 * sk + 8 * h;
                    const f32x4 c0 = *(const LAS f32x4*)(CBL + l * CB_LD + s0), c1 = *(const LAS f32x4*)(CBL + l * CB_LD + s0 + 4);
                    const f32x4 a0 = *(const LAS f32x4*)(acS + s0), a1 = *(const LAS f32x4*)(acS + s0 + 4);
                    const f32x4 d0 = *(const LAS f32x4*)(dtS + s0), d1 = *(const LAS f32x4*)(dtS + s0 + 4);
                    float wv[8];
#pragma unroll
                    for (int e = 0; e < 4; ++e) { wv[e] = c0[e] * __expf(al - a0[e]) * d0[e]; wv[4 + e] = c1[e] * __expf(al - a1[e]) * d1[e]; }
#pragma unroll
                    for (int e = 0; e < 8; ++e) { const int s = s0 + e; wv[e] = (s <= l) ? wv[e] : 0.f; if (s == l) wv[e] += Dh; }
                    const bf16x8 af = mk8(pk2(wv[0], wv[1]), pk2(wv[2], wv[3]), pk2(wv[4], wv[5]), pk2(wv[6], wv[7]));
                    const bf16x8 bfr = *(const LAS bf16x8*)(xrow + s0);
                    Y = MFMA32(af, bfr, Y);
                }
                bf16_t* mp = MIXIN + (size_t)(r0 + 32 * lb) * NMIX; const unsigned moff = (unsigned)(4 * h) * NMIX + hh * 64 + 32 * pbw + r;
#pragma unroll
                for (int i = 0; i < 16; ++i) {
                    const float z = __uint_as_float((zz[i] << (16 - 16 * lb)) & 0xffff0000u);
                    mp[moff + (unsigned)crow(i, 0) * NMIX] = to_bf(Y[i] * silu_f(z)); }
            }
        }
        {
            const float dA = __expf(acum_end);
#pragma unroll
            for (int nb = 0; nb < 4; ++nb) Hs[nb] = Hs[nb] * dA;
#pragma unroll
            for (int ks = 0; ks < 4; ++ks) {
                const int l0 = 16 * ks + 8 * h;
                const f32x4 a0 = *(const LAS f32x4*)(acS + l0), a1 = *(const LAS f32x4*)(acS + l0 + 4);
                const f32x4 d0 = *(const LAS f32x4*)(dtS + l0), d1 = *(const LAS f32x4*)(dtS + l0 + 4);
                float wl[8];
#pragma unroll
                for (int e = 0; e < 4; ++e) { wl[e] = d0[e] * __expf(acum_end - a0[e]); wl[4 + e] = d1[e] * __expf(acum_end - a1[e]); }
                const u32x4 xr = *(const LAS u32x4*)(xrow + l0);
                const bf16x8 xf = mk8(pk2(bf_lo(xr.x) * wl[0], bf_hi(xr.x) * wl[1]), pk2(bf_lo(xr.y) * wl[2], bf_hi(xr.y) * wl[3]),
                                      pk2(bf_lo(xr.z) * wl[4], bf_hi(xr.z) * wl[5]), pk2(bf_lo(xr.w) * wl[6], bf_hi(xr.w) * wl[7]));
#pragma unroll
                for (int nb = 0; nb < 4; ++nb) {
                    const bf16x8 af = *(const LAS bf16x8*)(BTL + (32 * nb + r) * XT_LD + l0);
                    Hs[nb] = MFMA32(af, xf, Hs[nb]);
                }
            }
            dec_total += acum_end;
        }
        __syncthreads();
    }
    if (MODE == 0) {
        float* hp = SLOC + (size_t)((b * NSC + sc) * 16 + hh) * 8192 + pbw * 1024 + lane;
#pragma unroll
        for (int nb = 0; nb < 4; ++nb)
#pragma unroll
            for (int i = 0; i < 16; ++i) hp[nb * 2048 + i * 64] = Hs[nb][i];
        if (lane == 0 && pbw == 0) DEC[(b * NSC + sc) * 16 + hh] = __expf(dec_total);
    }
    if (MODE == 2) {
        float* st = a.out + O_SSMS + (size_t)(b * 16 + hh) * 8192 + (32 * pbw + r) * 128 + 4 * h;
#pragma unroll
        for (int nb = 0; nb < 4; ++nb)
#pragma unroll
            for (int q = 0; q < 4; ++q) { f32x4 v; v.x = Hs[nb][4 * q]; v.y = Hs[nb][4 * q + 1]; v.z = Hs[nb][4 * q + 2]; v.w = Hs[nb][4 * q + 3];
                *(f32x4*)(st + 32 * nb + 8 * q) = v; }
    }
}

constexpr int VT_LD = 136, UG_LD = 264, L_VT = 1024, L_UG = 70656;
template <bool SAMPLE>
DI void gmlp_item(const DArgs& a, LAS unsigned char* lds, int item) {
    constexpr int T = SAMPLE ? 32 : 128;
    int tid = my_tid(a); asm volatile("" : "+v"(tid));
    const int lane = tid & 63, w = __builtin_amdgcn_readfirstlane(tid >> 6), r = lane & 31, h = lane >> 5;
    const bf16_t* PROJ = (const bf16_t*)(a.ws + OFF_PROJ); bf16_t* MIXIN = (bf16_t*)a.out;
    const int row0 = SAMPLE ? MP + item * 32 : item * 128;
    LAS float* st = (LAS float*)lds; LAS bf16_t* VT = (LAS bf16_t*)(lds + L_VT); LAS bf16_t* UG = (LAS bf16_t*)(lds + L_UG);
#pragma unroll 1
    for (int l8 = 0; l8 < T / 8; l8 += 8) {
        u32x4 q[8][2];
#pragma unroll
        for (int i = 0; i < 8; ++i) { const int l = w + 8 * (l8 + i); const bool on = (8 * (l8 + i) < T);
            const u32x4* vp = (const u32x4*)(PROJ + (size_t)(row0 + (on ? l : 0)) * NPROJ + V0) + 2 * lane; q[i][0] = vp[0]; q[i][1] = vp[1]; }
#pragma unroll
        for (int i = 0; i < 8; ++i) { const int l = w + 8 * (l8 + i);
            float v[16];
#pragma unroll
            for (int e = 0; e < 4; ++e) { v[2 * e] = bf_lo(q[i][0][e]); v[2 * e + 1] = bf_hi(q[i][0][e]); v[8 + 2 * e] = bf_lo(q[i][1][e]); v[9 + 2 * e] = bf_hi(q[i][1][e]); }
            float s = 0.f;
#pragma unroll
            for (int e = 0; e < 16; ++e) s += v[e];
            const float mu = wave_sum(s) * (1.f / 1024.f);
            float s2 = 0.f;
#pragma unroll
            for (int e = 0; e < 16; ++e) { const float d = v[e] - mu; s2 += d * d; }
            const float rstd = rsqrtf(wave_sum(s2) * (1.f / 1024.f) + EPS);
            if (lane == 0 && l < T) { st[2 * l] = mu; st[2 * l + 1] = rstd; } }
    }
    __syncthreads();
#pragma unroll 1
    for (int gp = 0; gp < 4; ++gp) {
        int tid_o = tid; asm volatile("" : "+v"(tid_o));
        {
            const int cp = tid_o & 127, rq = tid_o >> 7, c0 = gp * 256 + 2 * cp;
            const bool von = (rq * 32 < T);
            unsigned raw[32];
#pragma unroll
            for (int i = 0; i < 32; ++i) raw[i] = von ? *(const unsigned*)(PROJ + (size_t)(row0 + rq * 32 + i) * NPROJ + V0 + c0) : 0u;
            u32x4 uu[8], gg4[8];
#pragma unroll
            for (int q = 0; q < 8; ++q) { const int id = tid_o + 512 * q, row = id >> 5, c16 = id & 31; const bool on = row < T;
                const bf16_t* p = PROJ + (size_t)(row0 + (on ? row : 0)) * NPROJ + gp * 256 + c16 * 8;
                uu[q] = *(const u32x4*)(p + U0); gg4[q] = *(const u32x4*)(p + G0); }
            const float gv0 = a.in[I_GV][c0], gv1 = a.in[I_GV][c0 + 1], bv0 = a.in[I_BETAV][c0], bv1 = a.in[I_BETAV][c0 + 1];
#pragma unroll
            for (int blk = 0; blk < 4; ++blk) {
                const int l0 = rq * 32 + blk * 8;
                float n0[8], n1[8];
#pragma unroll
                for (int i = 0; i < 8; ++i) { const f32x2 ms = *(const LAS f32x2*)(st + 2 * (l0 + i));
                    n0[i] = von ? (bf_lo(raw[8 * blk + i]) - ms.x) * ms.y * gv0 + bv0 : 0.f; n1[i] = von ? (bf_hi(raw[8 * blk + i]) - ms.x) * ms.y * gv1 + bv1 : 0.f;
                    if (SAMPLE) { if (von) { f32x2 o = {n0[i], n1[i]}; *(f32x2*)(a.out + O_VS + (size_t)(item * 32 + l0 + i) * 1024 + c0) = o; } } }
                *(LAS bf16x8*)(VT + (2 * cp) * VT_LD + l0) = mk8(pk2(n0[0], n0[1]), pk2(n0[2], n0[3]), pk2(n0[4], n0[5]), pk2(n0[6], n0[7]));
                *(LAS bf16x8*)(VT + (2 * cp + 1) * VT_LD + l0) = mk8(pk2(n1[0], n1[1]), pk2(n1[2], n1[3]), pk2(n1[4], n1[5]), pk2(n1[6], n1[7]));
            }
#pragma unroll
            for (int q = 0; q < 8; ++q) { const int id = tid_o + 512 * q, row = id >> 5, c16 = id & 31;
                unsigned o[4];
#pragma unroll
                for (int e = 0; e < 4; ++e) o[e] = pk2(silu_f(bf_lo(gg4[q][e])) * bf_lo(uu[q][e]), silu_f(bf_hi(gg4[q][e])) * bf_hi(uu[q][e]));
                if (row < T) *(LAS bf16x8*)(UG + row * UG_LD + c16 * 8) = mk8(o[0], o[1], o[2], o[3]); }
        }
        __syncthreads();
        {
            const int lane2 = tid_o & 63, r = lane2 & 31, h = lane2 >> 5;
            const int gi = w >> 2, tq = w & 3, gg = 2 * gp + gi;
            if (32 * tq < T) {
                const int t = 32 * tq + r;
                const float* wrow = a.in[I_WS] + (size_t)(gg * 128 + t) * 128 + 8 * h;
                bf16x8 wf[8];
#pragma unroll
                for (int ks = 0; ks < 8; ++ks) {
                    if (ks < 2 * (tq + 1)) { const int s0 = 16 * ks + 8 * h;
                        const f32x4 w0 = *(const f32x4*)(wrow + 16 * ks), w1 = *(const f32x4*)(wrow + 16 * ks + 4);
                        float wv[8] = {w0.x, w0.y, w0.z, w0.w, w1.x, w1.y, w1.z, w1.w};
#pragma unroll
                        for (int e = 0; e < 8; ++e) wv[e] = (s0 + e <= t) ? wv[e] : 0.f;
                        wf[ks] = mk8(pk2(wv[0], wv[1]), pk2(wv[2], wv[3]), pk2(wv[4], wv[5]), pk2(wv[6], wv[7])); }
                    else wf[ks] = mk8(0u, 0u, 0u, 0u);
                }
                float bsv[16];
#pragma unroll
                for (int q = 0; q < 4; ++q) { const f32x4 bq = *(const f32x4*)(a.in[I_BS] + gg * 128 + 32 * tq + 8 * q + 4 * h);
                    bsv[4 * q] = bq.x; bsv[4 * q + 1] = bq.y; bsv[4 * q + 2] = bq.z; bsv[4 * q + 3] = bq.w; }
                f32x16 acc[4];
#pragma unroll
                for (int db = 0; db < 4; ++db)
#pragma unroll
                    for (int i = 0; i < 16; ++i) acc[db][i] = 0.f;
#pragma unroll
                for (int ks = 0; ks < 8; ++ks) {
                    if (ks < 2 * (tq + 1)) {
#pragma unroll
                        for (int db = 0; db < 4; ++db) {
                            const bf16x8 bfr = *(const LAS bf16x8*)(VT + (gi * 128 + 32 * db + r) * VT_LD + 16 * ks + 8 * h);
                            acc[db] = MFMA32(wf[ks], bfr, acc[db]);
                        }
                    }
                }
#pragma unroll
                for (int i = 0; i < 16; ++i) { LAS bf16_t* up = UG + (32 * tq + crow(i, h)) * UG_LD + gi * 128 + r;
#pragma unroll
                    for (int db = 0; db < 4; ++db) up[32 * db] = to_bf(bf1(up[32 * db]) * (acc[db][i] + bsv[i])); }
            }
        }
        __syncthreads();
        {
#pragma unroll
            for (int q = 0; q < 8; ++q) { const int id = tid_o + 512 * q, row = id >> 5, c16 = id & 31;
                if (row < T) *(u32x4*)(MIXIN + (size_t)(row0 + row) * NMIX + 1024 + gp * 256 + c16 * 8) = *(const LAS u32x4*)(UG + row * UG_LD + c16 * 8); }
        }
        __syncthreads();
    }
}

DI void phase3(const DArgs& a, LAS unsigned char* lds) {
    const int bid = blockIdx.x, G = gridDim.x;
#ifndef P3_PART
#define P3_PART 31
#endif
    if (P3_PART & 1) for (int it = bid; it < 256; it += G) { ssd_item<0>(a, lds, it >> 6, (it >> 5) & 1, (it >> 4) & 1, it & 15); __syncthreads(); }
    if (P3_PART & 2) for (int it = bid; it < 256; it += G) { gmlp_item<false>(a, lds, it); __syncthreads(); }
    if (P3_PART & 4) for (int it = bid; it < 128; it += G) { ssd_item<2>(a, lds, it >> 2, (it >> 1) & 1, it & 1, 0); __syncthreads(); }
    if (P3_PART & 8) for (int it = 0; it < 32; ++it) if ((it + 128) % G == bid) { gmlp_item<true>(a, lds, it); __syncthreads(); }
    const bf16_t* PROJ = (const bf16_t*)(a.ws + OFF_PROJ);
    for (int it = 0; it < 36; ++it) if ((it + 160) % G == bid) {
        const size_t rbase = (it < 4) ? (size_t)it * 8192 + 8189 : (size_t)MP + (size_t)(it - 4) * 32 + 29;
        float* o = a.out + ((it < 4) ? O_CONVP + (size_t)it * 4608 : O_CONVS + (size_t)(it - 4) * 4608);
        for (int e = my_tid(a); e < 4608; e += 512) { const int jj = e / 1536, c = e % 1536; o[e] = bf1(PROJ[(rbase + jj) * NPROJ + XBC0 + c]); }
    }
}
DI void phase4(const DArgs& a) {
    float* SLOC = (float*)(a.ws + OFF_SLOC); const float* DEC = (const float*)(a.ws + OFF_DEC);
    for (int e = blockIdx.x * 512 + my_tid(a); e < 131072; e += gridDim.x * 512) {
        const int bh = e >> 11, e4 = e & 2047, b = bh >> 4, head = bh & 15;
        f32x4 S[NSC];
#pragma unroll
        for (int sc = 0; sc < NSC; ++sc) S[sc] = *(const f32x4*)(SLOC + (size_t)((b * NSC + sc) * 16 + head) * 8192 + e4 * 4);
        f32x4 H = {0.f, 0.f, 0.f, 0.f};
#pragma unroll
        for (int sc = 0; sc < NSC; ++sc) { const float d = DEC[(b * NSC + sc) * 16 + head];
            *(f32x4*)(SLOC + (size_t)((b * NSC + sc) * 16 + head) * 8192 + e4 * 4) = H; H = H * d + S[sc]; }
        const int idx = e4 * 4, tile = idx >> 10, i = (idx >> 6) & 15, ln = idx & 63, nb = tile >> 1, pb = tile & 1;
        const int n = 32 * nb + crow(i, ln >> 5), p = 32 * pb + (ln & 31);
        float* o = a.out + O_SSMP + (size_t)((b * 16 + head) * 64 + p) * 128 + n;
        o[0] = H.x; o[128] = H.y; o[256] = H.z; o[384] = H.w;
    }
}
DI void phase5(const DArgs& a, LAS unsigned char* lds) {
    for (int it = blockIdx.x; it < 256; it += gridDim.x) { ssd_item<1>(a, lds, it >> 6, (it >> 5) & 1, (it >> 4) & 1, it & 15); __syncthreads(); }
}
DI void phase7(const DArgs& a) {
    const int tid = my_tid(a), lane = tid & 63, wave = tid >> 6;
    const int gw = blockIdx.x * 8 + wave, NGW = gridDim.x * 8;
    const float* mod = (const float*)(a.ws + OFF_MOD); const float* MIX = (const float*)(a.ws + OFF_MIX);
    const f32x4* gp4 = (const f32x4*)a.in[I_GPOST];
    for (int row = gw; row < MTOT; row += NGW) {
        const float* xr; int bi;
        if (row < MP) { xr = a.in[I_XP] + (size_t)row * DM; bi = row >> 13; } else { xr = a.in[I_XS] + (size_t)(row - MP) * DM; bi = 4 + ((row - MP) >> 5); }
        const f32x4* mr = (const f32x4*)(MIX + (size_t)row * DM);
        f32x4 v[4]; float ss = 0.f;
#pragma unroll
        for (int j = 0; j < 4; ++j) { v[j] = mr[lane + 64 * j]; ss += (v[j].x * v[j].x + v[j].y * v[j].y) + (v[j].z * v[j].z + v[j].w * v[j].w); }
        const float rs = rsqrtf(wave_sum(ss) * (1.f / DM) + EPS);
        const f32x4* gt4 = (const f32x4*)(mod + bi * 3072 + 2048);
#pragma unroll
        for (int j = 0; j < 4; ++j) { const int k4 = lane + 64 * j; const f32x4 x = ((const f32x4*)xr)[k4];
            *(f32x4*)(a.out + O_Y + (size_t)row * DM + 4 * k4) = x + gt4[k4] * (v[j] * rs * gp4[k4]); }
    }
}

#ifndef PH_MASK
#define PH_MASK 0xff
#endif
#define PH_ON(p) (((PH_MASK) >> (p)) & 1)
__global__ __launch_bounds__(512, 2) void fwd(Args a_in) {
    DArgs a; static_cast<Args&>(a) = a_in; a.wave_s = __builtin_amdgcn_readfirstlane(threadIdx.x >> 6);
    extern __shared__ __attribute__((aligned(16))) unsigned char shm[];
    LAS unsigned char* lds = (LAS unsigned char*)shm;
    cg::grid_group grid = cg::this_grid();
#ifndef DBL_MASK
#define DBL_MASK 0
#endif
#define RUN_PHASE(p, ...) if (PH_ON(p) && a.ph_lo <= (p) && (p) < a.ph_hi) { __VA_ARGS__; if ((DBL_MASK >> (p)) & 1) { grid.sync(); __VA_ARGS__; } } if (a.ph_lo <= (p) && (p) + 1 < a.ph_hi) grid.sync();
    RUN_PHASE(0, phase0(a, lds))
    RUN_PHASE(1, phase1(a))
    RUN_PHASE(2, { pg8::Gemm g{(const bf16_t*)a.out, (const bf16_t*)(a.ws + OFF_WT1), MTOT, NPAD, 1024};
            pg8::StaticOrder S; S.init(MTOT, NPAD, (int)gridDim.x, (int)blockIdx.x); EpiProj E{(bf16_t*)(a.ws + OFF_PROJ), (float*)(a.ws + OFF_DT)};
            pg8::gemm_phase<EpiProj, pg8::StaticOrder, true, true>(lds, g, S, E, my_tid(a)); })
    RUN_PHASE(3, phase3(a, lds))
    RUN_PHASE(4, phase4(a))
    RUN_PHASE(5, phase5(a, lds))
    RUN_PHASE(6, { pg8::Gemm g{(const bf16_t*)a.out, (const bf16_t*)(a.ws + OFF_WT2), MTOT, 1024, 2048};
            pg8::StaticOrder S; S.init(MTOT, 1024, (int)gridDim.x, (int)blockIdx.x); EpiF32 E{(float*)(a.ws + OFF_MIX), 1024};
            pg8::gemm_phase<EpiF32, pg8::StaticOrder, true, true>(lds, g, S, E, my_tid(a)); })
    if (PH_ON(7) && a.ph_lo <= 7 && 7 < a.ph_hi) phase7(a);
}

#ifndef N_LAUNCHES
#define N_LAUNCHES 1
#endif
extern "C" void kernel_launch(void* const* d_in, const int* in_sizes, int n_in, void* d_out, int out_size, void* d_ws, size_t ws_size, hipStream_t stream) {
    static int grid = 0;
    if (grid == 0) {
        if (n_in != 21 || (size_t)out_size != O_END || ws_size < WS_END) { fprintf(stderr, "kernel_launch: unexpected sizes n_in %d out %d ws %zu (need %zu)\n", n_in, out_size, ws_size, (size_t)WS_END); grid = -1; return; }
        int dev = 0, cus = 0, per_cu = 0;
        if (hipGetDevice(&dev) != hipSuccess || hipDeviceGetAttribute(&cus, hipDeviceAttributeMultiprocessorCount, dev) != hipSuccess) { grid = -1; return; }
        if (hipFuncSetAttribute((const void*)fwd, hipFuncAttributeMaxDynamicSharedMemorySize, LDS_BYTES) != hipSuccess) { fprintf(stderr, "kernel_launch: hipFuncSetAttribute failed\n"); grid = -1; return; }
        if (hipOccupancyMaxActiveBlocksPerMultiprocessor(&per_cu, (const void*)fwd, 512, LDS_BYTES) != hipSuccess || per_cu < 1) { fprintf(stderr, "kernel_launch: occupancy query says %d\n", per_cu); per_cu = 1; }
        (void)hipGetLastError();
        grid = cus;
    }
    if (grid < 0) return;
    Args a{};
    for (int i = 0; i < 21; ++i) a.in[i] = (const float*)d_in[i];
    a.out = (float*)d_out; a.ws = (unsigned char*)d_ws;
    if (N_LAUNCHES == 1) {
        a.ph_lo = 0; a.ph_hi = 8;
        void* args[] = {&a};
        hipError_t e = hipLaunchCooperativeKernel((const void*)fwd, dim3(grid), dim3(512), args, LDS_BYTES, stream);
        if (e != hipSuccess) fprintf(stderr, "kernel_launch: cooperative launch failed: %s (grid %d)\n", hipGetErrorString(e), grid);
    } else {
        for (int ph = 0; ph < 8; ++ph) { a.ph_lo = ph; a.ph_hi = ph + 1; hipLaunchKernelGGL(fwd, dim3(grid), dim3(512), LDS_BYTES, stream, a); }
    }
}
```
